# Optimizing an MI355X kernel written in HIP

```python
import math
import jax, jax.numpy as jnp
from jax import lax
import numpy as np

D_MODEL = 1024
BATCH = 8
SEQ = 2048
DEPTH = 2
DEC_BATCH = 128
DEC_SEQ = 4
PAST_LEN = 2048
PAGE_SIZE = 128

N_A_LAYERS = DEPTH // 2
N_B_LAYERS = DEPTH - N_A_LAYERS
HEAD_DIM = 64
MIX_WIDTH = 3 * D_MODEL // 4
MEM_WIDTH = D_MODEL - MIX_WIDTH
MEM_HEADS = MEM_WIDTH // HEAD_DIM
N_MEM = 256
SSM_GROUP = 16
SSM_GROUPS = MIX_WIDTH // SSM_GROUP
SSM_STATE = 64
DIL_GROUPS = ((128, 1), (512, 4), (2048, 16))
N_DIL = len(DIL_GROUPS)
ATT_HEADS = MIX_WIDTH // HEAD_DIM
HEADS_PER_GROUP = ATT_HEADS // N_DIL
IN_SPLITS = (MIX_WIDTH, 2 * MIX_WIDTH, 2 * MIX_WIDTH + MEM_WIDTH)
IN_WIDTH = 2 * MIX_WIDTH + 2 * MEM_WIDTH
OUT_WIDTH = MIX_WIDTH + MEM_WIDTH
DEEPNORM_ALPHA = (2.0 * DEPTH) ** 0.25
DEEPNORM_BETA = (8.0 * DEPTH) ** -0.25
LN_EPS = 1e-5
SCALE = HEAD_DIM ** -0.5
NEG_INF = -1e30
DT_MIN, DT_MAX = 1e-3, 1e-1

kernel_name = "yoco_s5_dilated_attention_decode_step"


def layer_norm(x, g, b):
    xf = x.astype(jnp.float32)
    mu = jnp.mean(xf, axis=-1, keepdims=True)
    var = jnp.mean(jnp.square(xf - mu), axis=-1, keepdims=True)
    return ((xf - mu) * lax.rsqrt(var + LN_EPS) * g + b).astype(x.dtype)


def alibi_slopes():
    return 2.0 ** (-8.0 * jnp.arange(1, ATT_HEADS + 1, dtype=jnp.float32) / ATT_HEADS)


def _linear_combine(left, right):
    a_l, b_l = left
    a_r, b_r = right
    return a_l * a_r, a_r * b_l + b_r


def s5_branch(u, h0_re, h0_im, lam_re, lam_im, log_dt, b_re, b_im, c_re, c_im, d_skip, w_glu, b_glu):
    f32 = jnp.float32
    Bn, T, _ = u.shape
    lam = lax.complex(jnp.minimum(lam_re.astype(f32), -1e-4), lam_im.astype(f32))
    dt = jnp.exp(log_dt.astype(f32))[:, None]
    lam_bar = jnp.exp(lam * dt)
    b_bar = ((lam_bar - 1.0) / lam)[:, :, None] * lax.complex(b_re.astype(f32), b_im.astype(f32))
    c = lax.complex(c_re.astype(f32), c_im.astype(f32))
    h0 = lax.complex(h0_re.astype(f32), h0_im.astype(f32))
    ug = u.astype(f32).reshape(Bn, T, SSM_GROUPS, SSM_GROUP)
    bu = jnp.einsum('btgc,gpc->btgp', ug.astype(jnp.complex64), b_bar)
    bu = bu.at[:, 0].add(lam_bar * h0)
    a = jnp.broadcast_to(lam_bar, bu.shape)
    _, h = lax.associative_scan(_linear_combine, (a, bu), axis=1)
    y = jnp.real(jnp.einsum('btgp,gcp->btgc', h, c)) + d_skip.astype(f32) * ug
    y = jax.nn.gelu(y.reshape(Bn, T, MIX_WIDTH))
    y = y * jax.nn.sigmoid(y @ w_glu.astype(f32) + b_glu.astype(f32))
    h_last = h[:, -1]
    return y, (jnp.real(h_last), jnp.imag(h_last))


def mem_attention(q, mem_k, mem_v):
    Bn, T, _ = q.shape
    q = q.reshape(Bn, T, MEM_HEADS, HEAD_DIM)
    s = jnp.einsum('bthe,bmhe->bhtm', q, mem_k).astype(jnp.float32) * SCALE
    p = jax.nn.softmax(s, axis=-1)
    o = jnp.einsum('bhtm,bmhe->bthe', p.astype(mem_v.dtype), mem_v)
    return o.reshape(Bn, T, MEM_WIDTH)


def _dilated_group_full(q, k, v, slopes, window, dil):
    f32 = jnp.float32
    Bn, S, H, E = q.shape
    n = window // dil
    L = S // dil
    nblk = -(-L // n)
    Lp = nblk * n

    def strided(t, front):
        t = t.reshape(Bn, L, dil, H, E).transpose(0, 2, 1, 3, 4)
        return jnp.pad(t, ((0, 0), (0, 0), (front, Lp - L), (0, 0), (0, 0)))

    def banded(t):
        t = strided(t, n).reshape(Bn, dil, nblk + 1, n, H, E)
        return jnp.concatenate([t[:, :, :-1], t[:, :, 1:]], axis=3)

    qb = strided(q, 0).reshape(Bn, dil, nblk, n, H, E)
    kb, vb = banded(k), banded(v)
    i = jnp.arange(n)[:, None]
    u = jnp.arange(2 * n)[None, :]
    delta = i + n - u
    key_pos = (jnp.arange(nblk)[:, None, None] - 1) * n + u
    valid = (delta >= 0) & (delta <= n) & (key_pos >= 0)
    bias = -slopes.astype(f32)[:, None, None] * (delta * dil).astype(f32)
    s = jnp.einsum('brjihe,brjuhe->brjhiu', qb, kb).astype(f32) * SCALE + bias
    s = jnp.where(valid[:, None], s, NEG_INF)
    lse = jax.nn.logsumexp(s, axis=-1)
    p = jnp.exp(s - lse[..., None])
    o = jnp.einsum('brjhiu,brjuhe->brjihe', p.astype(vb.dtype), vb)
    o = o.reshape(Bn, dil, Lp, H, E)[:, :, :L].transpose(0, 2, 1, 3, 4).reshape(Bn, S, H, E)
    lse = lse.transpose(0, 1, 2, 4, 3).reshape(Bn, dil, Lp, H)[:, :, :L]
    lse = lse.transpose(0, 2, 1, 3).reshape(Bn, S, H)
    return o, lse


def _dilated_group_cached(q, k_new, v_new, buf_k, buf_v, slopes, window, dil):
    f32 = jnp.float32
    T = q.shape[1]
    Lb = buf_k.shape[1]
    n = window // dil
    kc = jnp.concatenate([buf_k, k_new], axis=1)
    vc = jnp.concatenate([buf_v, v_new], axis=1)
    dist = jnp.arange(n + 1) * dil
    idx = Lb + jnp.arange(T)[:, None] - dist[None, :]
    valid = idx >= 0
    idx = jnp.maximum(idx, 0)
    kg = kc[:, idx]
    vg = vc[:, idx]
    bias = -slopes.astype(f32)[:, None, None] * dist.astype(f32)
    s = jnp.einsum('bthe,btmhe->bhtm', q, kg).astype(f32) * SCALE + bias
    s = jnp.where(valid, s, NEG_INF)
    lse = jax.nn.logsumexp(s, axis=-1)
    p = jnp.exp(s - lse[..., None])
    o = jnp.einsum('bhtm,btmhe->bthe', p.astype(vg.dtype), vg)
    return o, lse.transpose(0, 2, 1)


def _merge_groups(outs, lses):
    w = jax.nn.softmax(jnp.stack(lses, axis=0), axis=0)
    o = jnp.concatenate([outs[g].astype(jnp.float32) * w[g][..., None] for g in range(N_DIL)], axis=2)
    Bn, T = o.shape[0], o.shape[1]
    return o.reshape(Bn, T, MIX_WIDTH)


def dilated_attention_prompt(q, kv):
    slopes = alibi_slopes()
    outs, lses = [], []
    for g, (win, dil) in enumerate(DIL_GROUPS):
        hs = slice(g * HEADS_PER_GROUP, (g + 1) * HEADS_PER_GROUP)
        o, lse = _dilated_group_full(q[:, :, hs], kv[:, :, 0, hs], kv[:, :, 1, hs], slopes[hs], win, dil)
        outs.append(o)
        lses.append(lse)
    return _merge_groups(outs, lses)


def dilated_attention_sample(q, kv, buffers):
    slopes = alibi_slopes()
    outs, lses = [], []
    for g, (win, dil) in enumerate(DIL_GROUPS):
        hs = slice(g * HEADS_PER_GROUP, (g + 1) * HEADS_PER_GROUP)
        buf = buffers[g]
        o, lse = _dilated_group_cached(q[:, :, hs], kv[:, :, 0, hs], kv[:, :, 1, hs],
                                       buf[:, :, 0], buf[:, :, 1], slopes[hs], win, dil)
        outs.append(o)
        lses.append(lse)
    return _merge_groups(outs, lses)


def mixer_layer(x, mem_k, mem_v, branch, w_in, w_out, ln_g, ln_b):
    proj = x @ w_in
    u, gate, mq, mgate = jnp.split(proj, IN_SPLITS, axis=-1)
    y, aux = branch(u)
    y = y.astype(x.dtype) * jax.nn.silu(gate)
    m = mem_attention(mq, mem_k, mem_v).astype(x.dtype) * jax.nn.silu(mgate)
    out = jnp.concatenate([y, m], axis=-1) @ w_out
    return layer_norm(DEEPNORM_ALPHA * x + out, ln_g, ln_b), aux


def run_trunk(x, mem_kv, h0_re, h0_im, attn_fn, w_in, w_out, ln_g, ln_b, ssm_lambda_re, ssm_lambda_im,
              ssm_log_dt, ssm_b_re, ssm_b_im, ssm_c_re, ssm_c_im, ssm_d, w_glu, b_glu, w_kv_shared):
    h_re, h_im = [], []
    kv = None
    for l in range(DEPTH):
        mem_k, mem_v = mem_kv[l][:, :, 0], mem_kv[l][:, :, 1]
        if l < N_A_LAYERS:
            def branch(u, l=l):
                return s5_branch(u, h0_re[l], h0_im[l], ssm_lambda_re[l], ssm_lambda_im[l], ssm_log_dt[l],
                                 ssm_b_re[l], ssm_b_im[l], ssm_c_re[l], ssm_c_im[l], ssm_d[l], w_glu[l], b_glu[l])
            x, (hr, hi) = mixer_layer(x, mem_k, mem_v, branch, w_in[l], w_out[l], ln_g[l], ln_b[l])
            h_re.append(hr)
            h_im.append(hi)
            if l == N_A_LAYERS - 1:
                Bn, T, _ = x.shape
                kv = (x @ w_kv_shared).reshape(Bn, T, 2, ATT_HEADS, HEAD_DIM)
        else:
            def branch(u, kv=kv):
                Bn, T, _ = u.shape
                return attn_fn(u.reshape(Bn, T, ATT_HEADS, HEAD_DIM), kv), None
            x, _ = mixer_layer(x, mem_k, mem_v, branch, w_in[l], w_out[l], ln_g[l], ln_b[l])
    return x, jnp.stack(h_re, axis=0), jnp.stack(h_im, axis=0), kv


def setup_inputs(seed: int = 0) -> dict:
    key = jax.random.key(seed)
    ks = jax.random.split(key, 28)
    f32 = jnp.float32

    def nrm(k, shape, scale=1.0):
        return jax.random.normal(k, shape, f32) * scale

    win_lens = [min(w, PAST_LEN) for (w, _) in DIL_GROUPS]
    n_idx = jnp.arange(SSM_STATE, dtype=f32)
    return {
        "x_prompt": nrm(ks[0], (BATCH, SEQ, D_MODEL)),
        "x_sample": nrm(ks[1], (DEC_BATCH, DEC_SEQ, D_MODEL)),
        "cache_mem_kv": nrm(ks[2], (DEPTH, DEC_BATCH, N_MEM, 2, MEM_HEADS, HEAD_DIM)),
        "state_ssm_re": nrm(ks[3], (N_A_LAYERS, DEC_BATCH, SSM_GROUPS, SSM_STATE), 0.3),
        "state_ssm_im": nrm(ks[4], (N_A_LAYERS, DEC_BATCH, SSM_GROUPS, SSM_STATE), 0.3),
        "cache_dil1_kv": nrm(ks[5], (DEC_BATCH, win_lens[0], 2, HEADS_PER_GROUP, HEAD_DIM)),
        "cache_dil4_kv": nrm(ks[6], (DEC_BATCH, win_lens[1], 2, HEADS_PER_GROUP, HEAD_DIM)),
        "cache_dil16_kv": nrm(ks[7], (DEC_BATCH, win_lens[2], 2, HEADS_PER_GROUP, HEAD_DIM)),
        "mem_prompt": nrm(ks[8], (BATCH, N_MEM, D_MODEL)),
        "w_in": nrm(ks[9], (DEPTH, D_MODEL, IN_WIDTH), D_MODEL ** -0.5),
        "w_out": nrm(ks[10], (DEPTH, OUT_WIDTH, D_MODEL), OUT_WIDTH ** -0.5 * DEEPNORM_BETA),
        "ln_g": 1.0 + nrm(ks[11], (DEPTH, D_MODEL), 0.01),
        "ln_b": nrm(ks[12], (DEPTH, D_MODEL), 0.01),
        "w_mem_kv": jnp.concatenate([nrm(ks[13], (DEPTH, D_MODEL, MEM_WIDTH), D_MODEL ** -0.5),
                                     nrm(ks[14], (DEPTH, D_MODEL, MEM_WIDTH), D_MODEL ** -0.5 * DEEPNORM_BETA)], axis=-1),
        "ssm_lambda_re": -0.5 + nrm(ks[15], (N_A_LAYERS, SSM_GROUPS, SSM_STATE), 0.01),
        "ssm_lambda_im": math.pi * n_idx + nrm(ks[16], (N_A_LAYERS, SSM_GROUPS, SSM_STATE), 0.01),
        "ssm_log_dt": jax.random.uniform(ks[17], (N_A_LAYERS, SSM_GROUPS), f32, math.log(DT_MIN), math.log(DT_MAX)),
        "ssm_b_re": nrm(ks[18], (N_A_LAYERS, SSM_GROUPS, SSM_STATE, SSM_GROUP), (2 * SSM_GROUP) ** -0.5),
        "ssm_b_im": nrm(ks[19], (N_A_LAYERS, SSM_GROUPS, SSM_STATE, SSM_GROUP), (2 * SSM_GROUP) ** -0.5),
        "ssm_c_re": nrm(ks[20], (N_A_LAYERS, SSM_GROUPS, SSM_GROUP, SSM_STATE), 0.5),
        "ssm_c_im": nrm(ks[21], (N_A_LAYERS, SSM_GROUPS, SSM_GROUP, SSM_STATE), 0.5),
        "ssm_d": nrm(ks[22], (N_A_LAYERS, SSM_GROUPS, SSM_GROUP)),
        "w_glu": nrm(ks[23], (N_A_LAYERS, MIX_WIDTH, MIX_WIDTH), MIX_WIDTH ** -0.5),
        "b_glu": nrm(ks[24], (N_A_LAYERS, MIX_WIDTH), 0.01),
        "w_kv_shared": jnp.concatenate([nrm(ks[25], (D_MODEL, MIX_WIDTH), D_MODEL ** -0.5),
                                        nrm(ks[26], (D_MODEL, MIX_WIDTH), D_MODEL ** -0.5 * DEEPNORM_BETA)], axis=-1),
    }


def reference(x_prompt, x_sample, cache_mem_kv, state_ssm_re, state_ssm_im, cache_dil1_kv, cache_dil4_kv,
              cache_dil16_kv, mem_prompt, w_in, w_out, ln_g, ln_b, w_mem_kv, ssm_lambda_re, ssm_lambda_im,
              ssm_log_dt, ssm_b_re, ssm_b_im, ssm_c_re, ssm_c_im, ssm_d, w_glu, b_glu, w_kv_shared):
    weights = (w_in, w_out, ln_g, ln_b, ssm_lambda_re, ssm_lambda_im, ssm_log_dt, ssm_b_re, ssm_b_im,
               ssm_c_re, ssm_c_im, ssm_d, w_glu, b_glu, w_kv_shared)

    Bp = x_prompt.shape[0]
    mem_kv_prompt = jnp.einsum('bmd,ldk->lbmk', mem_prompt, w_mem_kv).reshape(
        DEPTH, Bp, N_MEM, 2, MEM_HEADS, HEAD_DIM)
    zeros = jnp.zeros((N_A_LAYERS, Bp, SSM_GROUPS, SSM_STATE), jnp.float32)
    y_prompt, ssm_re_prompt, ssm_im_prompt, kv_p = run_trunk(
        x_prompt, mem_kv_prompt, zeros, zeros, dilated_attention_prompt, *weights)
    S = kv_p.shape[1]
    win_p = [kv_p[:, S - min(win, S):, :, g * HEADS_PER_GROUP:(g + 1) * HEADS_PER_GROUP]
             for g, (win, _) in enumerate(DIL_GROUPS)]
    dil1_kv_prompt, dil4_kv_prompt, dil16_kv_prompt = win_p

    buffers = (cache_dil1_kv, cache_dil4_kv, cache_dil16_kv)

    def attn_sample(q, kv):
        return dilated_attention_sample(q, kv, buffers)

    y_sample, ssm_re_sample, ssm_im_sample, kv_s = run_trunk(
        x_sample, cache_mem_kv, state_ssm_re, state_ssm_im, attn_sample, *weights)
    win_s = []
    for g, (win, _) in enumerate(DIL_GROUPS):
        full = jnp.concatenate([buffers[g], kv_s[:, :, :, g * HEADS_PER_GROUP:(g + 1) * HEADS_PER_GROUP]], axis=1)
        keep = min(win, full.shape[1])
        win_s.append(full[:, full.shape[1] - keep:])
    dil1_kv_sample, dil4_kv_sample, dil16_kv_sample = win_s

    return (y_prompt, y_sample, mem_kv_prompt, ssm_re_prompt, ssm_im_prompt, dil1_kv_prompt, dil4_kv_prompt,
            dil16_kv_prompt, ssm_re_sample, ssm_im_sample, dil1_kv_sample, dil4_kv_sample, dil16_kv_sample)
```

```cpp
#include <hip/hip_runtime.h>
#include <math.h>
#include <stdint.h>

namespace nv {
constexpr int D = 1024, BP = 8, SEQ = 2048, BS = 128, TS = 4;
constexpr int MP = BP * SEQ, MS = BS * TS, M = MP + MS;
constexpr int INW = 2048, MIX = 768, NMEM = 256, G = 48, P = 64, C = 16, NH = 12;
constexpr float ALPHA = 1.41421356237309515f, LN_EPS = 1e-5f;

constexpr size_t O_Y = 0, O_MEMKV = 17301504, O_SRE_P = 19398656, O_SIM_P = 19423232, O_D1P = 19447808, O_D4P = 19972096,
                 O_D16P = 22069248, O_SRE_S = 30457856, O_SIM_S = 30851072, O_D1S = 31244288, O_D4S = 39632896, O_D16S = 73187328;

__global__ __launch_bounds__(256) void gemm_f32(const float* __restrict__ A, int lda, const float* __restrict__ B, int ldb,
                                               float* __restrict__ Cm, int ldc, int K) {
    __shared__ float As[16][68];
    __shared__ float Bs[16][68];
    const int tx = threadIdx.x & 15, ty = threadIdx.x >> 4;
    const int m0 = blockIdx.y * 64, n0 = blockIdx.x * 64;
    float acc[4][4];
#pragma unroll
    for (int i = 0; i < 4; ++i)
#pragma unroll
        for (int j = 0; j < 4; ++j) acc[i][j] = 0.f;
    for (int k0 = 0; k0 < K; k0 += 16) {
#pragma unroll
        for (int r = 0; r < 4; ++r) {
            const int i = threadIdx.x + r * 256;
            const int m = i >> 4, k = i & 15;
            As[k][m] = A[(size_t)(m0 + m) * lda + k0 + k];
            const int kk = i >> 6, n = i & 63;
            Bs[kk][n] = B[(size_t)(k0 + kk) * ldb + n0 + n];
        }
        __syncthreads();
#pragma unroll
        for (int k = 0; k < 16; ++k) {
            float a[4], b[4];
#pragma unroll
            for (int i = 0; i < 4; ++i) { a[i] = As[k][ty * 4 + i]; b[i] = Bs[k][tx * 4 + i]; }
#pragma unroll
            for (int i = 0; i < 4; ++i)
#pragma unroll
                for (int j = 0; j < 4; ++j) acc[i][j] += a[i] * b[j];
        }
        __syncthreads();
    }
#pragma unroll
    for (int i = 0; i < 4; ++i)
#pragma unroll
        for (int j = 0; j < 4; ++j) Cm[(size_t)(m0 + ty * 4 + i) * ldc + n0 + tx * 4 + j] = acc[i][j];
}

__global__ void s5_tables(const float* lam_re, const float* lam_im, const float* log_dt, const float* b_re, const float* b_im,
                          float* lb_re, float* lb_im, float* bb_re, float* bb_im) {
    const int i = blockIdx.x * blockDim.x + threadIdx.x;
    if (i >= G * P) return;
    const int g = i / P;
    const double lr = fmin((double)lam_re[i], -1e-4), li = (double)lam_im[i];
    const double dt = exp((double)log_dt[g]);
    const double mag = exp(lr * dt), ang = li * dt;
    const double zr = mag * cos(ang), zi = mag * sin(ang);
    lb_re[i] = (float)zr; lb_im[i] = (float)zi;
    const double a = zr - 1.0, b = zi, den = lr * lr + li * li;
    const double cr = (a * lr + b * li) / den, ci = (b * lr - a * li) / den;
    for (int c = 0; c < C; ++c) {
        const double br = b_re[i * C + c], bi = b_im[i * C + c];
        bb_re[i * C + c] = (float)(cr * br - ci * bi);
        bb_im[i * C + c] = (float)(cr * bi + ci * br);
    }
}

__global__ __launch_bounds__(64) void s5_scan(const float* proj, int row0, int T, const float* h0_re, const float* h0_im,
                                              const float* lb_re, const float* lb_im, const float* bb_re, const float* bb_im,
                                              float* hs_re, float* hs_im, float* out_re, float* out_im) {
    const int b = blockIdx.x / G, g = blockIdx.x % G, p = threadIdx.x;
    const int gp = g * P + p;
    const float lr = lb_re[gp], li = lb_im[gp];
    float br[16], bi[16];
#pragma unroll
    for (int c = 0; c < 16; ++c) { br[c] = bb_re[gp * C + c]; bi[c] = bb_im[gp * C + c]; }
    float hr = h0_re ? h0_re[(size_t)b * G * P + gp] : 0.f, hi = h0_im ? h0_im[(size_t)b * G * P + gp] : 0.f;
    for (int t = 0; t < T; ++t) {
        const size_t row = (size_t)row0 + (size_t)b * T + t;
        const float* u = proj + row * INW + g * C;
        float bur = 0.f, bui = 0.f;
#pragma unroll
        for (int c = 0; c < 16; ++c) { const float uv = u[c]; bur += br[c] * uv; bui += bi[c] * uv; }
        const float nr = lr * hr - li * hi + bur, ni = lr * hi + li * hr + bui;
        hr = nr; hi = ni;
        hs_re[row * (G * P) + gp] = hr; hs_im[row * (G * P) + gp] = hi;
    }
    out_re[(size_t)b * G * P + gp] = hr; out_im[(size_t)b * G * P + gp] = hi;
}

__device__ __forceinline__ float gelu_tanh(float x) { return 0.5f * x * (1.f + tanhf(0.7978845608028654f * (x + 0.044715f * x * x * x))); }
__device__ __forceinline__ float sigmoidf_(float x) { return 1.f / (1.f + expf(-x)); }
__device__ __forceinline__ float siluf_(float x) { return x * sigmoidf_(x); }

__global__ void s5_y(const float* proj, const float* hs_re, const float* hs_im, const float* c_re, const float* c_im, const float* dsk, float* Y) {
    const size_t i = (size_t)blockIdx.x * blockDim.x + threadIdx.x;
    if (i >= (size_t)M * MIX) return;
    const size_t row = i / MIX; const int ch = (int)(i % MIX), g = ch / C;
    const float* hr = hs_re + row * (G * P) + g * P; const float* hi = hs_im + row * (G * P) + g * P;
    const float* cr = c_re + (size_t)ch * P; const float* ci = c_im + (size_t)ch * P;
    float y = 0.f;
    for (int p = 0; p < P; ++p) y += cr[p] * hr[p] - ci[p] * hi[p];
    y += dsk[ch] * proj[row * INW + ch];
    Y[i] = gelu_tanh(y);
}

__global__ void glu_gate(const float* Y, const float* Z, const float* b_glu, const float* proj, float* A1) {
    const size_t i = (size_t)blockIdx.x * blockDim.x + threadIdx.x;
    if (i >= (size_t)M * MIX) return;
    const size_t row = i / MIX; const int c = (int)(i % MIX);
    const float y = Y[i], z = Z[i] + b_glu[c];
    A1[row * D + c] = y * sigmoidf_(z) * siluf_(proj[row * INW + MIX + c]);
}

__device__ __forceinline__ float wave_max(float v) { for (int o = 32; o > 0; o >>= 1) v = fmaxf(v, __shfl_xor(v, o)); return v; }
__device__ __forceinline__ float wave_sum(float v) { for (int o = 32; o > 0; o >>= 1) v += __shfl_xor(v, o); return v; }

__global__ __launch_bounds__(64) void mem_attn(const float* proj, const float* memkv_p, const float* memkv_s, float* A1) {
    __shared__ float qs[64]; __shared__ float ps[256];
    const int row = blockIdx.x >> 2, h = blockIdx.x & 3, lane = threadIdx.x;
    const float* kv = row < MP ? memkv_p + (size_t)(row / SEQ) * NMEM * 512 : memkv_s + (size_t)((row - MP) / TS) * NMEM * 512;
    qs[lane] = proj[(size_t)row * INW + 1536 + h * 64 + lane];
    __syncthreads();
    float s[4]; float mx = -1e30f;
#pragma unroll
    for (int mm = 0; mm < 4; ++mm) {
        const float* k = kv + (size_t)(mm * 64 + lane) * 512 + h * 64;
        float a = 0.f;
        for (int e = 0; e < 64; ++e) a += qs[e] * k[e];
        s[mm] = a * 0.125f; mx = fmaxf(mx, s[mm]);
    }
    mx = wave_max(mx);
    float sum = 0.f;
#pragma unroll
    for (int mm = 0; mm < 4; ++mm) { s[mm] = expf(s[mm] - mx); sum += s[mm]; }
    sum = wave_sum(sum);
    const float inv = 1.f / sum;
#pragma unroll
    for (int mm = 0; mm < 4; ++mm) ps[mm * 64 + lane] = s[mm] * inv;
    __syncthreads();
    float o = 0.f;
    for (int m = 0; m < NMEM; ++m) o += ps[m] * kv[(size_t)m * 512 + 256 + h * 64 + lane];
    A1[(size_t)row * D + MIX + h * 64 + lane] = o * siluf_(proj[(size_t)row * INW + 1792 + h * 64 + lane]);
}

__global__ __launch_bounds__(256) void ln_res(const float* X, const float* O, const float* g, const float* b, float* out) {
    __shared__ float red[8];
    const size_t row = blockIdx.x; const int t = threadIdx.x;
    float r[4]; float s = 0.f;
#pragma unroll
    for (int j = 0; j < 4; ++j) { const int c = t + j * 256; r[j] = ALPHA * X[row * D + c] + O[row * D + c]; s += r[j]; }
    s = wave_sum(s);
    if ((t & 63) == 0) red[t >> 6] = s;
    __syncthreads();
    const float mean = (red[0] + red[1] + red[2] + red[3]) * (1.f / D);
    float q = 0.f;
#pragma unroll
    for (int j = 0; j < 4; ++j) { const float d = r[j] - mean; q += d * d; }
    q = wave_sum(q);
    if ((t & 63) == 0) red[4 + (t >> 6)] = q;
    __syncthreads();
    const float var = (red[4] + red[5] + red[6] + red[7]) * (1.f / D);
    const float rstd = rsqrtf(var + LN_EPS);
#pragma unroll
    for (int j = 0; j < 4; ++j) { const int c = t + j * 256; out[row * D + c] = (r[j] - mean) * rstd * g[c] + b[c]; }
}

__global__ void kv_window(float* out, int win, int nb, int T, int rowbase, int g, const float* KV, const float* buf) {
    const size_t idx = (size_t)blockIdx.x * blockDim.x + threadIdx.x;
    if (idx >= (size_t)nb * win * 512) return;
    const int c = (int)(idx % 512); const int i = (int)((idx / 512) % win); const int b = (int)(idx / ((size_t)512 * win));
    const int s = c >> 8, hh = (c >> 6) & 3, e = c & 63;
    float v;
    if (buf == nullptr) {
        const size_t row = (size_t)rowbase + (size_t)b * T + (T - win) + i;
        v = KV[row * 1536 + s * 768 + (g * 4 + hh) * 64 + e];
    } else {
        if (i < win - T) v = buf[((size_t)b * win + i + T) * 512 + c];
        else { const size_t row = (size_t)rowbase + (size_t)b * T + (i - (win - T)); v = KV[row * 1536 + s * 768 + (g * 4 + hh) * 64 + e]; }
    }
    out[idx] = v;
}

__global__ __launch_bounds__(64) void dil_attn(const float* proj, const float* KV, const float* buf1, const float* buf4, const float* buf16,
                                               float* ATT, float* LSE) {
    __shared__ float qs[64]; __shared__ float ps[132];
    const int row = blockIdx.x / NH, h = blockIdx.x % NH, lane = threadIdx.x;
    const int g = h >> 2, hh = h & 3;
    const int dil = g == 0 ? 1 : (g == 1 ? 4 : 16);
    const int Lb = g == 0 ? 128 : (g == 1 ? 512 : 2048);
    const float* buf = g == 0 ? buf1 : (g == 1 ? buf4 : buf16);
    const float slope = exp2f(-8.0f * (float)(h + 1) / 12.0f);
    const bool prompt = row < MP;
    const int b = prompt ? row / SEQ : (row - MP) / TS, t = prompt ? row % SEQ : (row - MP) % TS;
    qs[lane] = proj[(size_t)row * INW + h * 64 + lane];
    __syncthreads();
    float s[3]; bool ok[3]; float mx = -1e30f;
#pragma unroll
    for (int mm = 0; mm < 3; ++mm) {
        const int m = mm * 64 + lane;
        s[mm] = -1e30f; ok[mm] = false;
        if (m <= 128) {
            const float* kp = nullptr;
            if (prompt) { const int pos = t - m * dil; if (pos >= 0) kp = KV + ((size_t)b * SEQ + pos) * 1536 + h * 64; }
            else { const int idx = Lb + t - m * dil;
                   kp = idx < Lb ? buf + ((size_t)b * Lb + idx) * 512 + hh * 64 : KV + ((size_t)MP + (size_t)b * TS + (idx - Lb)) * 1536 + h * 64; }
            if (kp) { float a = 0.f; for (int e = 0; e < 64; ++e) a += qs[e] * kp[e];
                      s[mm] = a * 0.125f - slope * (float)(m * dil); ok[mm] = true; }
        }
        mx = fmaxf(mx, s[mm]);
    }
    mx = wave_max(mx);
    float sum = 0.f;
#pragma unroll
    for (int mm = 0; mm < 3; ++mm) { s[mm] = ok[mm] ? expf(s[mm] - mx) : 0.f; sum += s[mm]; }
    sum = wave_sum(sum);
    const float inv = 1.f / sum;
#pragma unroll
    for (int mm = 0; mm < 3; ++mm) { const int m = mm * 64 + lane; if (m <= 128) ps[m] = s[mm] * inv; }
    __syncthreads();
    float o = 0.f;
    for (int m = 0; m <= 128; ++m) {
        const float* vp;
        if (prompt) { const int pos = t - m * dil; if (pos < 0) break; vp = KV + ((size_t)b * SEQ + pos) * 1536 + 768 + h * 64; }
        else { const int idx = Lb + t - m * dil;
               vp = idx < Lb ? buf + ((size_t)b * Lb + idx) * 512 + 256 + hh * 64 : KV + ((size_t)MP + (size_t)b * TS + (idx - Lb)) * 1536 + 768 + h * 64; }
        o += ps[m] * vp[lane];
    }
    ATT[(size_t)row * MIX + h * 64 + lane] = o;
    if (lane == 0) LSE[(size_t)row * NH + h] = mx + logf(sum);
}

__global__ void merge_gate(const float* ATT, const float* LSE, const float* proj, float* A1) {
    const size_t i = (size_t)blockIdx.x * blockDim.x + threadIdx.x;
    if (i >= (size_t)M * MIX) return;
    const size_t row = i / MIX; const int c = (int)(i % MIX), h = c >> 6, j = h & 3;
    const float l0 = LSE[row * NH + j], l1 = LSE[row * NH + 4 + j], l2 = LSE[row * NH + 8 + j];
    const float mx = fmaxf(l0, fmaxf(l1, l2));
    const float den = expf(l0 - mx) + expf(l1 - mx) + expf(l2 - mx);
    const float w = expf(LSE[row * NH + h] - mx) / den;
    A1[row * D + c] = ATT[i] * w * siluf_(proj[row * INW + MIX + c]);
}
}

extern "C" void kernel_launch(void* const* d_in, const int* in_sizes, int n_in, void* d_out, int out_size, void* d_ws, size_t ws_size,
                              hipStream_t stream) {
    using namespace nv;
    const float* x_prompt = (const float*)d_in[0]; const float* x_sample = (const float*)d_in[1];
    const float* cache_mem = (const float*)d_in[2]; const float* st_re = (const float*)d_in[3]; const float* st_im = (const float*)d_in[4];
    const float* c1 = (const float*)d_in[5]; const float* c4 = (const float*)d_in[6]; const float* c16 = (const float*)d_in[7];
    const float* mem_prompt = (const float*)d_in[8]; const float* w_in = (const float*)d_in[9]; const float* w_out = (const float*)d_in[10];
    const float* ln_g = (const float*)d_in[11]; const float* ln_b = (const float*)d_in[12]; const float* w_mem = (const float*)d_in[13];
    const float* lam_re = (const float*)d_in[14]; const float* lam_im = (const float*)d_in[15]; const float* log_dt = (const float*)d_in[16];
    const float* b_re = (const float*)d_in[17]; const float* b_im = (const float*)d_in[18]; const float* c_re = (const float*)d_in[19];
    const float* c_im = (const float*)d_in[20]; const float* dsk = (const float*)d_in[21]; const float* w_glu = (const float*)d_in[22];
    const float* b_glu = (const float*)d_in[23]; const float* w_kv = (const float*)d_in[24];
    float* out = (float*)d_out;
    float* ws = (float*)d_ws;
    size_t o = 0;
    auto take = [&](size_t n) { float* p = ws + o; o += (n + 63) & ~(size_t)63; return p; };
    float* X0 = take((size_t)M * D);
    float* X1 = take((size_t)M * D);
    float* PROJ = take((size_t)M * INW);
    float* HSR = take((size_t)M * G * P);
    float* HSI = take((size_t)M * G * P);
    float* Y = take((size_t)M * MIX);
    float* Z = take((size_t)M * MIX);
    float* A1 = take((size_t)M * D);
    float* OO = take((size_t)M * D);
    float* KV = take((size_t)M * 1536);
    float* LSE = take((size_t)M * NH);
    float* LBR = take(G * P); float* LBI = take(G * P); float* BBR = take(G * P * C); float* BBI = take(G * P * C);
    float* ATT = Y;

    hipMemcpyAsync(X0, x_prompt, (size_t)MP * D * 4, hipMemcpyDeviceToDevice, stream);
    hipMemcpyAsync(X0 + (size_t)MP * D, x_sample, (size_t)MS * D * 4, hipMemcpyDeviceToDevice, stream);
    for (int l = 0; l < 2; ++l)
        gemm_f32<<<dim3(512 / 64, (BP * NMEM) / 64), 256, 0, stream>>>(mem_prompt, D, w_mem + (size_t)l * D * 512, 512, out + O_MEMKV + (size_t)l * BP * NMEM * 512, 512, D);
    s5_tables<<<(G * P + 63) / 64, 64, 0, stream>>>(lam_re, lam_im, log_dt, b_re, b_im, LBR, LBI, BBR, BBI);
    gemm_f32<<<dim3(INW / 64, M / 64), 256, 0, stream>>>(X0, D, w_in, INW, PROJ, INW, D);
    s5_scan<<<BP * G, 64, 0, stream>>>(PROJ, 0, SEQ, nullptr, nullptr, LBR, LBI, BBR, BBI, HSR, HSI, out + O_SRE_P, out + O_SIM_P);
    s5_scan<<<BS * G, 64, 0, stream>>>(PROJ, MP, TS, st_re, st_im, LBR, LBI, BBR, BBI, HSR, HSI, out + O_SRE_S, out + O_SIM_S);
    {
        const size_t n = (size_t)M * MIX;
        s5_y<<<(unsigned)((n + 255) / 256), 256, 0, stream>>>(PROJ, HSR, HSI, c_re, c_im, dsk, Y);
        gemm_f32<<<dim3(MIX / 64, M / 64), 256, 0, stream>>>(Y, MIX, w_glu, MIX, Z, MIX, MIX);
        glu_gate<<<(unsigned)((n + 255) / 256), 256, 0, stream>>>(Y, Z, b_glu, PROJ, A1);
    }
    mem_attn<<<M * 4, 64, 0, stream>>>(PROJ, out + O_MEMKV, cache_mem, A1);
    gemm_f32<<<dim3(D / 64, M / 64), 256, 0, stream>>>(A1, D, w_out, D, OO, D, D);
    ln_res<<<M, 256, 0, stream>>>(X0, OO, ln_g, ln_b, X1);
    gemm_f32<<<dim3(1536 / 64, M / 64), 256, 0, stream>>>(X1, D, w_kv, 1536, KV, 1536, D);
    {
        const int wins[3] = {128, 512, 2048};
        float* outs_p[3] = {out + O_D1P, out + O_D4P, out + O_D16P};
        float* outs_s[3] = {out + O_D1S, out + O_D4S, out + O_D16S};
        const float* bufs[3] = {c1, c4, c16};
        for (int g = 0; g < 3; ++g) {
            size_t n = (size_t)BP * wins[g] * 512;
            kv_window<<<(unsigned)((n + 255) / 256), 256, 0, stream>>>(outs_p[g], wins[g], BP, SEQ, 0, g, KV, nullptr);
            n = (size_t)BS * wins[g] * 512;
            kv_window<<<(unsigned)((n + 255) / 256), 256, 0, stream>>>(outs_s[g], wins[g], BS, TS, MP, g, KV, bufs[g]);
        }
    }
    gemm_f32<<<dim3(INW / 64, M / 64), 256, 0, stream>>>(X1, D, w_in + (size_t)D * INW, INW, PROJ, INW, D);
    dil_attn<<<M * NH, 64, 0, stream>>>(PROJ, KV, c1, c4, c16, ATT, LSE);
    {
        const size_t n = (size_t)M * MIX;
        merge_gate<<<(unsigned)((n + 255) / 256), 256, 0, stream>>>(ATT, LSE, PROJ, A1);
    }
    mem_attn<<<M * 4, 64, 0, stream>>>(PROJ, out + O_MEMKV + (size_t)BP * NMEM * 512, cache_mem + (size_t)BS * NMEM * 512, A1);
    gemm_f32<<<dim3(D / 64, M / 64), 256, 0, stream>>>(A1, D, w_out + (size_t)D * D, D, OO, D, D);
    ln_res<<<M, 256, 0, stream>>>(X1, OO, ln_g + D, ln_b + D, out + O_Y);
}
```

```cpp
#include <hip/hip_runtime.h>
#include <cstdio>
#include <cstdint>
#include <math.h>
namespace pg8 {
#define PG8_LAS __attribute__((address_space(3)))
typedef unsigned short bf16_t;
typedef short bf16x8 __attribute__((ext_vector_type(8)));
typedef float f32x4 __attribute__((ext_vector_type(4)));
typedef float f32x2 __attribute__((ext_vector_type(2)));
typedef unsigned u32x4 __attribute__((ext_vector_type(4)));
typedef unsigned u32x2 __attribute__((ext_vector_type(2)));
constexpr int BM = 256, BK = 64, HALF = 128, HTB = HALF * BK * 2, STAGE_BYTES = 8 * HTB, NXCD = 8, WGM = 8;

__host__ __device__ __forceinline__ int lds_byte(int r, int c) { const int st = (r >> 4) * 2 + (c >> 5), rr = r & 15, cc = c & 31, ob = rr * 64 + cc * 2; return st * 1024 + (ob ^ (((ob >> 9) & 1) << 5)); }
__host__ __device__ __forceinline__ void stage_rc(int b, int& R, int& C) { const int st = b / 1024, sb = b % 1024, swz = sb ^ (((sb >> 9) & 1) << 5); R = (st >> 1) * 16 + swz / 64; C = (st & 1) * 32 + (swz % 64) / 2; }
__host__ __device__ __forceinline__ int perm32(int rho) { const int n = rho >> 4, i = rho & 15; return 8 * (i >> 2) + 4 * n + (i & 3); }

struct Unit { int pm, pn, gb; };
struct Gemm { const bf16_t* A; const bf16_t* Bt; int lda, ldb, K; size_t bsA, bsB; };

struct StaticOrder {
    int nM, nN, nwg, G, c;
    __device__ void init(int M, int N, int G_, int c_) { nM = M / BM; nN = N / BM; nwg = nM * nN; G = G_; c = c_; }
    __device__ bool next(int i, Unit& u) const {
        const long L = (long)i * G + c; if (L >= nwg) return false;
        int wgid = (int)L; { const int q = nwg / NXCD, r = nwg % NXCD, xcd = wgid % NXCD, off = wgid / NXCD; wgid = (xcd < r ? xcd * (q + 1) : r * (q + 1) + (xcd - r) * q) + off; }
        const int nig = WGM * nN, gid = wgid / nig, fm = gid * WGM, gsz = (nM - fm) < WGM ? (nM - fm) : WGM;
        u.pm = fm + ((wgid % nig) % gsz); u.pn = (wgid % nig) / gsz; u.gb = 0; return true;
    }
};
struct BatchOrder {
    int nM, nwg, G, c;
    __device__ void init(int nB, int nM_, int G_, int c_) { nM = nM_; nwg = nB * nM_; G = G_; c = c_; }
    __device__ bool next(int i, Unit& u) const { const long L = (long)i * G + c; if (L >= nwg) return false; u.gb = (int)L / nM; u.pm = (int)L % nM; u.pn = 0; return true; }
};

__device__ __forceinline__ unsigned cvt_pk_bf16(float lo, float hi) { unsigned r; asm volatile("v_cvt_pk_bf16_f32 %0, %1, %2" : "=v"(r) : "v"(lo), "v"(hi)); return r; }
__device__ __forceinline__ float bf_lo(unsigned w) { return __uint_as_float(w << 16); }
__device__ __forceinline__ float bf_hi(unsigned w) { return __uint_as_float(w & 0xffff0000u); }

template <class Epi, class Sched, bool ALIGN_EPI>
__device__ __forceinline__ void gemm_phase(PG8_LAS unsigned char* lds, const Gemm g, const Sched& S, const Epi& E) {
    const int tid = threadIdx.x, wid = __builtin_amdgcn_readfirstlane(tid >> 6), lane = tid & 63, wr = wid >> 2, wc = wid & 3, fr = lane & 15, fq = lane >> 4;
    const int K = g.K, nt = K / BK;
    unsigned voffA[2], voffB[2];
#pragma unroll
    for (int i = 0; i < 2; ++i) { int R, C; stage_rc(tid * 16 + i * 8192, R, C); const int Rb = Epi::PERM ? ((R & ~31) + perm32(R & 31)) : R;
        voffA[i] = (unsigned)(R * g.lda + C) * 2u; voffB[i] = (unsigned)(Rb * g.ldb + C) * 2u; }
    const size_t kstep = (size_t)(BK * 2);
    const size_t hstepA = (size_t)HALF * g.lda * 2, hstepB = (size_t)HALF * g.ldb * 2;
    const size_t tstepA = 2 * hstepA, tstepB = 2 * hstepB;
    const unsigned ldsw = (unsigned)wid * 1024u;
    const int aoff = lds_byte(wr * 64 + fr, fq * 8), boff = lds_byte(wc * 32 + fr, fq * 8);
#define PG8_SA(b, h) (((b) * 2 + (h)) * HTB)
#define PG8_SB(b, h) ((4 + (b) * 2 + (h)) * HTB)
#define PG8_STAGE(bufoff, gbase, voff) do { _Pragma("unroll") for (int _i = 0; _i < 2; ++_i) \
        __builtin_amdgcn_global_load_lds((const unsigned*)((const char*)(gbase) + (voff)[_i]), (PG8_LAS unsigned*)(lds + (bufoff) + ldsw + _i * 8192), 16, 0, 0); } while (0)
#define PG8_LDA(dst, b, h) do { _Pragma("unroll") for (int m = 0; m < 4; ++m) _Pragma("unroll") for (int k = 0; k < 2; ++k) dst[m][k] = *(const PG8_LAS bf16x8*)(lds + PG8_SA(b, h) + aoff + m * 2048 + k * 1024); } while (0)
#define PG8_LDB(dst, b, h) do { _Pragma("unroll") for (int n = 0; n < 2; ++n) _Pragma("unroll") for (int k = 0; k < 2; ++k) dst[n][k] = *(const PG8_LAS bf16x8*)(lds + PG8_SB(b, h) + boff + n * 2048 + k * 1024); } while (0)
#define PG8_MMA(ai, bj, At, Bt) do { __builtin_amdgcn_s_setprio(1); _Pragma("unroll") for (int m = 0; m < 4; ++m) _Pragma("unroll") for (int n = 0; n < 2; ++n) _Pragma("unroll") for (int k = 0; k < 2; ++k) \
        acc[ai][bj][m][n] = __builtin_amdgcn_mfma_f32_16x16x32_bf16(Bt[n][k], At[m][k], acc[ai][bj][m][n], 0, 0, 0); __builtin_amdgcn_s_setprio(0); } while (0)
#define PG8_WAIT_V(n) asm volatile("s_waitcnt vmcnt(" #n ")" ::: "memory")
#define PG8_WAIT_L(n) asm volatile("s_waitcnt lgkmcnt(" #n ")" ::: "memory")
#define PG8_BAR __builtin_amdgcn_s_barrier()
#define PG8_SCHED __builtin_amdgcn_sched_barrier(0)
#define PG8_APTR(u) ((const char*)g.A + ((size_t)(u).gb * g.bsA) * 2 + (size_t)(u).pm * tstepA)
#define PG8_BPTR(u) ((const char*)g.Bt + ((size_t)(u).gb * g.bsB) * 2 + (size_t)(u).pn * tstepB)
    Unit cur, nxt; int ui = 0;
    if (!S.next(0, cur)) return;
    f32x4 acc[2][2][4][2];
#pragma unroll
    for (int a = 0; a < 2; ++a)
#pragma unroll
        for (int b = 0; b < 2; ++b)
#pragma unroll
            for (int m = 0; m < 4; ++m)
#pragma unroll
                for (int n = 0; n < 2; ++n) acc[a][b][m][n] = (f32x4){0.f, 0.f, 0.f, 0.f};
    bf16x8 At[4][2], B0[2][2], B1[2][2];
    const char* cA = PG8_APTR(cur); const char* cB = PG8_BPTR(cur);
    PG8_STAGE(PG8_SB(0, 0), cB, voffB); PG8_STAGE(PG8_SB(0, 1), cB + hstepB, voffB); PG8_STAGE(PG8_SA(0, 0), cA, voffA); PG8_STAGE(PG8_SA(0, 1), cA + hstepA, voffA);
    if (wr == 1) PG8_BAR;
    PG8_WAIT_V(2); PG8_BAR;
    PG8_STAGE(PG8_SB(1, 0), cB + kstep, voffB); PG8_STAGE(PG8_SA(1, 0), cA + kstep, voffA); PG8_STAGE(PG8_SB(1, 1), cB + hstepB + kstep, voffB);
    PG8_WAIT_V(6); PG8_BAR;
    for (;;) {
        const bool has_next = S.next(ui + 1, nxt);
        const char* nA = has_next ? PG8_APTR(nxt) : cA; const char* nB = has_next ? PG8_BPTR(nxt) : cB;
        for (int t = 0; t < nt; t += 2) {
            const bool last = (t == nt - 2);
            const char* a1 = cA + (size_t)(t + 1) * kstep;
            const char* a2 = last ? nA : cA + (size_t)(t + 2) * kstep; const char* b2 = last ? nB : cB + (size_t)(t + 2) * kstep;
            const char* a3 = a2 + kstep; const char* b3 = b2 + kstep;
            PG8_LDB(B0, 0, 0); PG8_LDB(B1, 0, 1); PG8_SCHED; PG8_LDA(At, 0, 0); PG8_STAGE(PG8_SA(1, 1), a1 + hstepA, voffA);
            PG8_WAIT_V(8); PG8_WAIT_L(0); PG8_BAR; PG8_MMA(0, 0, At, B0); PG8_MMA(0, 1, At, B1); PG8_BAR; PG8_SCHED;
            PG8_LDA(At, 0, 1); PG8_STAGE(PG8_SB(0, 0), b2, voffB); PG8_STAGE(PG8_SB(0, 1), b2 + hstepB, voffB); PG8_STAGE(PG8_SA(0, 0), a2, voffA);
            PG8_WAIT_V(8); PG8_WAIT_L(0); PG8_BAR; PG8_MMA(1, 0, At, B0); PG8_MMA(1, 1, At, B1); PG8_BAR; PG8_SCHED;
            PG8_LDB(B0, 1, 0); PG8_LDB(B1, 1, 1); PG8_SCHED; PG8_LDA(At, 1, 0); PG8_STAGE(PG8_SA(0, 1), a2 + hstepA, voffA);
            PG8_WAIT_V(8); PG8_WAIT_L(0); PG8_BAR; PG8_MMA(0, 0, At, B0); PG8_MMA(0, 1, At, B1); PG8_BAR; PG8_SCHED;
            PG8_LDA(At, 1, 1); PG8_STAGE(PG8_SB(1, 0), b3, voffB); PG8_STAGE(PG8_SB(1, 1), b3 + hstepB, voffB); PG8_STAGE(PG8_SA(1, 0), a3, voffA);
            PG8_WAIT_V(8); PG8_WAIT_L(0); PG8_BAR; PG8_MMA(1, 0, At, B0); PG8_MMA(1, 1, At, B1); PG8_BAR; PG8_SCHED;
        }
        if constexpr (ALIGN_EPI) { if (wr == 0) PG8_BAR; }
        E(acc, cur, wr, wc, fr, fq);
        if (!has_next) break;
#pragma unroll
        for (int a = 0; a < 2; ++a)
#pragma unroll
            for (int b = 0; b < 2; ++b)
#pragma unroll
                for (int m = 0; m < 4; ++m)
#pragma unroll
                    for (int n = 0; n < 2; ++n) acc[a][b][m][n] = (f32x4){0.f, 0.f, 0.f, 0.f};
        cur = nxt; cA = nA; cB = nB; ++ui;
        if constexpr (ALIGN_EPI) { if (wr == 1) PG8_BAR; }
    }
    PG8_WAIT_V(0);
    if constexpr (!ALIGN_EPI) { if (wr == 0) PG8_BAR; }
    PG8_BAR;
#undef PG8_SA
#undef PG8_SB
#undef PG8_STAGE
#undef PG8_LDA
#undef PG8_LDB
#undef PG8_MMA
#undef PG8_WAIT_V
#undef PG8_WAIT_L
#undef PG8_BAR
#undef PG8_SCHED
#undef PG8_APTR
#undef PG8_BPTR
}
}
constexpr int NWAVES = 8;
constexpr int DM = 1024, BP = 8, SEQ = 2048, BS = 128, TS = 4;
constexpr int MP = BP * SEQ, MS = BS * TS, MT = MP + MS;
constexpr int INW = 2048, MIX = 768, NMEM = 256, NG = 48, NP = 64, NC = 16, NH = 12;
constexpr int PRW = 1280;
constexpr int KVW = 3584;
constexpr int UGK = 384;
constexpr float ALPHA = 1.41421356237309515f, LN_EPS = 1e-5f;
constexpr size_t O_Y = 0, O_MEMKV = 17301504, O_SRE_P = 19398656, O_SIM_P = 19423232, O_D1P = 19447808, O_D4P = 19972096,
                 O_D16P = 22069248, O_SRE_S = 30457856, O_SIM_S = 30851072, O_D1S = 31244288, O_D4S = 39632896, O_D16S = 73187328;
constexpr size_t MiB = 1u << 20;
constexpr size_t WS_CTL = 0, CTL_ZERO_BYTES = 1 * MiB;
constexpr size_t WS_WIN0 = 1 * MiB;
constexpr size_t WS_WB1 = 5 * MiB;
constexpr size_t WS_WOUT0 = 12 * MiB;
constexpr size_t WS_WOUT1 = 14 * MiB;
constexpr size_t WS_WGLU = 16 * MiB;
constexpr size_t WS_WMEM = 18 * MiB;
constexpr size_t WS_MEMB = 20 * MiB;
constexpr size_t WS_PT = 24 * MiB;
constexpr size_t WS_TQ = 30 * MiB;
constexpr size_t WS_TAB = 39 * MiB;
constexpr size_t WS_MKVB = 40 * MiB;
constexpr size_t WS_XB = 44 * MiB;
constexpr size_t WS_UGH = 78 * MiB;
constexpr size_t WS_US = 114 * MiB;
constexpr size_t WS_PROJR = 115 * MiB;
constexpr size_t WS_SST = 157 * MiB;
constexpr size_t WS_Y = 181 * MiB;
constexpr size_t WS_A1 = 206 * MiB;
constexpr size_t WS_R = 240 * MiB;
constexpr size_t WS_X1 = 307 * MiB;
constexpr size_t WS_X1B = 374 * MiB;
constexpr size_t WS_KVP = 408 * MiB;
constexpr size_t WS_ATT = 524 * MiB;
constexpr size_t WS_LSE = 549 * MiB;
constexpr size_t WS_END = 551 * MiB;
constexpr int TB_L16R = 0, TB_L16I = 3072, TB_LBR = 6144, TB_LBI = 9216, TB_BBR = 12288, TB_BBI = 12288 + 49152;
constexpr int CW_BAR = 4096;

constexpr int RING_OFF = 0, RING_BYTES = 131072;
constexpr int LDSCTL_OFF = RING_BYTES, MISC_OFF = LDSCTL_OFF + 320;
constexpr int LDS_BYTES = 147456;

#define GAS __attribute__((address_space(1)))
#define LAS __attribute__((address_space(3)))
typedef unsigned short bf16;
typedef unsigned v4u __attribute__((ext_vector_type(4)));
typedef unsigned v2u __attribute__((ext_vector_type(2)));
typedef float f32x4 __attribute__((ext_vector_type(4)));
typedef short bf16x8 __attribute__((ext_vector_type(8)));
typedef GAS unsigned gu32;
#define RLX_AGENT __ATOMIC_RELAXED, __HIP_MEMORY_SCOPE_AGENT
#define LDS_WAIT() asm volatile("s_waitcnt lgkmcnt(0)" ::: "memory")
#define VM_WAIT() asm volatile("s_waitcnt vmcnt(0)" ::: "memory")
__device__ __forceinline__ unsigned f2bf(float f) { unsigned u = __builtin_bit_cast(unsigned, f); return (u + 0x7fffu + ((u >> 16) & 1u)) >> 16; }
__device__ __forceinline__ unsigned pk2(float lo, float hi) { return f2bf(lo) | (f2bf(hi) << 16); }
__device__ __forceinline__ float bf2f(unsigned short h) { return __uint_as_float((unsigned)h << 16); }

#define XB_TMO      128
#define XB_XCNT(j)  (256  + 64 * (j))
#define XB_XSUB(j)  (1280 + 64 * (j))
#define XB_XGEN(j)  (2304 + 64 * (j))
#define XB_TOP      3328
#define XB_TOPGEN   3392
#define XCD_BAR_WORDS 3456
#define XB_SPIN_CAP (1u << 18)
__device__ __forceinline__ unsigned xb_ld(unsigned* p)              { return __hip_atomic_load(p, __ATOMIC_RELAXED, __HIP_MEMORY_SCOPE_AGENT); }
__device__ __forceinline__ unsigned xb_add(unsigned* p, unsigned v) { return __hip_atomic_fetch_add(p, v, __ATOMIC_RELAXED, __HIP_MEMORY_SCOPE_AGENT); }
__device__ __forceinline__ unsigned xb_xcc_id() { return (unsigned)__builtin_amdgcn_s_getreg((3 << 11) | 20) & 0xFu; }
#define XB_SPIN(cond, bar) do { unsigned _sp = 0; while (cond) { __builtin_amdgcn_s_sleep(1); \
    if ((++_sp & 255u) == 0u) { if (xb_ld(&(bar)[XB_TMO])) break; if (_sp > XB_SPIN_CAP) { atomicAdd(&(bar)[XB_TMO], 1u); break; } } } } while (0)
struct XcdBarrier { unsigned* bar; unsigned x; volatile LAS unsigned* st; };
__device__ __forceinline__ XcdBarrier xcd_barrier_post(unsigned* bar, volatile LAS unsigned* st) {
    XcdBarrier b; b.bar = bar; b.x = xb_xcc_id(); b.st = st;
    if (threadIdx.x == 0) (void)xb_add(&bar[XB_XCNT(b.x)], 1u);
    return b;
}
__device__ __forceinline__ void xcd_barrier_complete(unsigned* bar, unsigned x, unsigned& nloc, unsigned& nx) {
    const unsigned G = gridDim.x * gridDim.y * gridDim.z;
    unsigned sum, cnt, mine, sp = 0u;
    for (;;) {
        sum = 0u; cnt = 0u; mine = 0u;
#pragma unroll
        for (unsigned j = 0; j < 16; ++j) { const unsigned c = xb_ld(&bar[XB_XCNT(j)]); sum += c; cnt += (c > 0u) ? 1u : 0u; mine = (j == x) ? c : mine; }
        if (sum == G) break;
        __builtin_amdgcn_s_sleep(1);
        if ((++sp & 255u) == 0u) { if (xb_ld(&bar[XB_TMO])) break; if (sp > XB_SPIN_CAP) { atomicAdd(&bar[XB_TMO], 1u); break; } }
    }
    nloc = mine > 0u ? mine : 1u; nx = cnt > 0u ? cnt : 1u;
}
__device__ __forceinline__ void xcd_barrier(const XcdBarrier& b) {
    asm volatile("s_waitcnt vmcnt(0)" ::: "memory");
    __syncthreads();
    if (threadIdx.x == 0) {
        unsigned* bar = b.bar;
        __builtin_amdgcn_s_waitcnt(0);
        unsigned nloc = b.st[0], nx = b.st[1];
        if (nloc == 0u) { xcd_barrier_complete(bar, b.x, nloc, nx); b.st[0] = nloc; b.st[1] = nx; }
        const unsigned old = xb_add(&bar[XB_XSUB(b.x)], 1u);
        const unsigned gen = old / nloc;
        if (old + 1u == (gen + 1u) * nloc) {
            __builtin_amdgcn_fence(__ATOMIC_RELEASE, "agent");
            asm volatile("s_waitcnt vmcnt(0)" ::: "memory");
            const unsigned og = xb_add(&bar[XB_TOP], 1u);
            const unsigned tg = og / nx;
            if (og + 1u == (tg + 1u) * nx) xb_add(&bar[XB_TOPGEN], 1u);
            else XB_SPIN(xb_ld(&bar[XB_TOPGEN]) == tg, bar);
            __builtin_amdgcn_fence(__ATOMIC_ACQUIRE, "agent");
            xb_add(&bar[XB_XGEN(b.x)], 1u);
            asm volatile("s_waitcnt vmcnt(0)" ::: "memory");
        } else {
            XB_SPIN(xb_ld(&bar[XB_XGEN(b.x)]) == gen, bar);
            __builtin_amdgcn_fence(__ATOMIC_ACQUIRE, "agent");
            asm volatile("s_waitcnt vmcnt(0)" ::: "memory");
        }
    }
    __syncthreads();
}

struct Frame {
    LAS unsigned char* lds;
    volatile LAS unsigned* MISC;
    gu32* ctl;
    int tid, lane, wave;
    int vcu, G;
    unsigned char* ws;
    float* out;
};
__device__ __forceinline__ float wave_sum(float v) {
#pragma unroll
    for (int o = 1; o < 64; o <<= 1) v += __shfl_xor(v, o);
    return v;
}
__device__ __forceinline__ float wave_max(float v) {
#pragma unroll
    for (int o = 1; o < 64; o <<= 1) v = fmaxf(v, __shfl_xor(v, o));
    return v;
}
__device__ __forceinline__ int opaque_i(int x) { asm volatile("" : "+v"(x)); return x; }
__device__ __forceinline__ void p0_transpose_item(const float* W, int K, int N, bf16* WT, int row_off, LAS float* scr, int item, int lane) {
    const int nblk = N / 32, kb = item / nblk, nb = item % nblk, k0 = 64 * kb, n0 = 32 * nb;
#pragma unroll 8
    for (int i = 0; i < 32; ++i) { const int kk = 2 * i + (lane >> 5); scr[kk * 33 + (lane & 31)] = W[(size_t)(k0 + kk) * N + n0 + (lane & 31)]; }
    LDS_WAIT(); asm volatile("" ::: "memory");
    const int c = lane & 7;
#pragma unroll
    for (int j = 0; j < 4; ++j) { const int n = (lane >> 3) + 8 * j; const LAS float* s = scr + (8 * c) * 33 + n;
        v4u o; o.x = pk2(s[0 * 33], s[1 * 33]); o.y = pk2(s[2 * 33], s[3 * 33]); o.z = pk2(s[4 * 33], s[5 * 33]); o.w = pk2(s[6 * 33], s[7 * 33]);
        *(GAS v4u*)(WT + (size_t)(row_off + n0 + n) * K + k0 + 8 * c) = o; }
    LDS_WAIT(); asm volatile("" ::: "memory");
}
__device__ __forceinline__ void row_to_bf16(const float* xrow, bf16* orow, int lane) {
    const GAS f32x4* xr = (const GAS f32x4*)xrow + lane;
    GAS unsigned long long* o8 = (GAS unsigned long long*)orow + lane;
#pragma unroll
    for (int j = 0; j < 4; ++j) { const f32x4 v = xr[64 * j]; o8[64 * j] = (unsigned long long)pk2(v.x, v.y) | ((unsigned long long)pk2(v.z, v.w) << 32); }
}
__device__ __forceinline__ void s5_tables_group(int g, const float* lam_re, const float* lam_im, const float* log_dt, const float* b_re, const float* b_im,
                                                const float* c_re, const float* c_im, const float* dsk, bf16* PT, bf16* TQ, float* TAB, LAS float* L, int tid) {
    LAS float* pwr = L;
    LAS float* pwi = L + 1088;
    LAS float* cre = L + 2176;
    LAS float* cim = L + 3200;
    LAS float* bbr = L + 4224;
    LAS float* bbi = L + 5248;
    LAS float* dk = L + 6272;
    LAS float* Kd = L + 6288;
    {
        const int p = tid & 63, dd = tid >> 6, gp = g * 64 + p;
        const double lr = fmin((double)lam_re[gp], -1e-4), li = (double)lam_im[gp], dt = exp((double)log_dt[g]);
        for (int d = dd; d <= 16; d += 8) {
            const double mag = exp((double)d * lr * dt), ang = (double)d * li * dt;
            pwr[d * 64 + p] = (float)(mag * cos(ang)); pwi[d * 64 + p] = (float)(mag * sin(ang));
            if (d == 16) { TAB[TB_L16R + gp] = (float)(mag * cos(ang)); TAB[TB_L16I + gp] = (float)(mag * sin(ang)); }
            if (d == 1) { TAB[TB_LBR + gp] = (float)(mag * cos(ang)); TAB[TB_LBI + gp] = (float)(mag * sin(ang)); }
        }
        if (dd == 0) {
            const double mag = exp(lr * dt), ang = li * dt, zr = mag * cos(ang), zi = mag * sin(ang);
            const double a = zr - 1.0, b = zi, den = lr * lr + li * li;
            const double cr = (a * lr + b * li) / den, ci = (b * lr - a * li) / den;
            for (int c = 0; c < 16; ++c) {
                const double br = b_re[gp * 16 + c], bi = b_im[gp * 16 + c];
                const float vr = (float)(cr * br - ci * bi), vi = (float)(cr * bi + ci * br);
                bbr[p * 16 + c] = vr; bbi[p * 16 + c] = vi;
                TAB[TB_BBR + gp * 16 + c] = vr; TAB[TB_BBI + gp * 16 + c] = vi;
            }
        }
        for (int i = tid; i < 1024; i += 512) { cre[i] = c_re[g * 1024 + i]; cim[i] = c_im[g * 1024 + i]; }
        if (tid < 16) dk[tid] = dsk[g * 16 + tid];
    }
    __syncthreads();
    for (int r = 0; r < 8; ++r) {
        const int idx = tid + 512 * r, d = idx >> 8, c = (idx >> 4) & 15, c2 = idx & 15;
        float s = 0.f;
        for (int p = 0; p < 64; ++p) {
            const float zr = cre[c * 64 + p] * pwr[d * 64 + p] - cim[c * 64 + p] * pwi[d * 64 + p];
            const float zi = cre[c * 64 + p] * pwi[d * 64 + p] + cim[c * 64 + p] * pwr[d * 64 + p];
            s += zr * bbr[p * 16 + c2] - zi * bbi[p * 16 + c2];
        }
        Kd[idx] = s;
    }
    __syncthreads();
    bf16* tq = TQ + (size_t)g * 256 * 384;
    for (int q = tid; q < 256 * 48; q += 512) {
        const int row = q / 48, kc = (q % 48) * 8, j = row >> 4, c = row & 15;
        float v[8];
        if (kc < 256) {
            const int i = kc >> 4, c0 = kc & 15;
#pragma unroll
            for (int e = 0; e < 8; ++e) { float x = 0.f; if (i <= j) { x = Kd[((j - i) << 8) + (c << 4) + c0 + e]; if (i == j && c == c0 + e) x += dk[c]; } v[e] = x; }
        } else {
            const int n0 = kc - 256;
#pragma unroll
            for (int e = 0; e < 8; ++e) { const int n = n0 + e, p = n & 63;
                const float zr = cre[c * 64 + p] * pwr[(j + 1) * 64 + p] - cim[c * 64 + p] * pwi[(j + 1) * 64 + p];
                const float zi = cre[c * 64 + p] * pwi[(j + 1) * 64 + p] + cim[c * 64 + p] * pwr[(j + 1) * 64 + p];
                v[e] = n < 64 ? zr : -zi; }
        }
        v4u o; o.x = pk2(v[0], v[1]); o.y = pk2(v[2], v[3]); o.z = pk2(v[4], v[5]); o.w = pk2(v[6], v[7]);
        *(GAS v4u*)(tq + (size_t)row * 384 + kc) = o;
    }
    bf16* pt = PT + (size_t)g * 256 * 256;
    for (int q = tid; q < 256 * 32; q += 512) {
        const int n = q >> 5, kc = (q & 31) * 8, i = kc >> 4, c0 = kc & 15, p = n & 63;
        float v[8];
#pragma unroll
        for (int e = 0; e < 8; ++e) {
            float x = 0.f;
            if (n < 128) { const float ar = pwr[(15 - i) * 64 + p], ai = pwi[(15 - i) * 64 + p], br = bbr[p * 16 + c0 + e], bi = bbi[p * 16 + c0 + e];
                x = n < 64 ? (ar * br - ai * bi) : (ar * bi + ai * br); }
            v[e] = x;
        }
        v4u o; o.x = pk2(v[0], v[1]); o.y = pk2(v[2], v[3]); o.z = pk2(v[4], v[5]); o.w = pk2(v[6], v[7]);
        *(GAS v4u*)(pt + (size_t)n * 256 + kc) = o;
    }
    __syncthreads();
}
__device__ __forceinline__ void copy_cache(const float* buf, float* out, int win, int gthread, int nthreads) {
    const size_t per_b = (size_t)(win - 4) * 128;
    const size_t total = per_b * BS;
    for (size_t i = gthread; i < total; i += nthreads) {
        const size_t b = i / per_b, r = i % per_b;
        const f32x4 v = __builtin_nontemporal_load((const f32x4*)buf + b * (size_t)win * 128 + 512 + r);
        __builtin_nontemporal_store(v, (f32x4*)out + b * (size_t)win * 128 + r);
    }
}
__device__ __forceinline__ void p0_prologue(Frame& F, const float* const* in) {
    const int gw = F.vcu * NWAVES + F.wave, NGW = F.G * NWAVES;
    if (F.vcu < NG)
        s5_tables_group(F.vcu, in[14], in[15], in[16], in[17], in[18], in[19], in[20], in[21], (bf16*)(F.ws + WS_PT), (bf16*)(F.ws + WS_TQ), (float*)(F.ws + WS_TAB),
                        (LAS float*)(F.lds + RING_OFF), F.tid);
    LAS float* scr = (LAS float*)(F.lds + RING_OFF + F.wave * 16384);
    constexpr int I0 = 16 * 64, I1 = 16 * 48, I2 = 16 * 64, I3 = 16 * 32, I4 = 16 * 32, I5 = 12 * 24, I6 = 16 * 16, I7 = 16 * 16;
    constexpr int NITEMS = I0 + I1 + I2 + I3 + I4 + I5 + I6 + I7;
    const float* w_in = in[9]; const float* w_out = in[10]; const float* w_mem = in[13]; const float* w_glu = in[22]; const float* w_kv = in[24];
    for (int it = gw; it < NITEMS; it += NGW) {
        int r = it;
        if (r < I0) { p0_transpose_item(w_in, 1024, 2048, (bf16*)(F.ws + WS_WIN0), 0, scr, r, F.lane); continue; } r -= I0;
        if (r < I1) { p0_transpose_item(w_kv, 1024, 1536, (bf16*)(F.ws + WS_WB1), 0, scr, r, F.lane); continue; } r -= I1;
        if (r < I2) { p0_transpose_item(w_in + (size_t)1024 * 2048, 1024, 2048, (bf16*)(F.ws + WS_WB1), 1536, scr, r, F.lane); continue; } r -= I2;
        if (r < I3) { p0_transpose_item(w_out, 1024, 1024, (bf16*)(F.ws + WS_WOUT0), 0, scr, r, F.lane); continue; } r -= I3;
        if (r < I4) { p0_transpose_item(w_out + (size_t)1024 * 1024, 1024, 1024, (bf16*)(F.ws + WS_WOUT1), 0, scr, r, F.lane); continue; } r -= I4;
        if (r < I5) { p0_transpose_item(w_glu, 768, 768, (bf16*)(F.ws + WS_WGLU), 0, scr, r, F.lane); continue; } r -= I5;
        if (r < I6) { p0_transpose_item(w_mem, 1024, 512, (bf16*)(F.ws + WS_WMEM), 0, scr, r, F.lane); continue; } r -= I6;
        p0_transpose_item(w_mem + (size_t)1024 * 512, 1024, 512, (bf16*)(F.ws + WS_WMEM), 512, scr, r, F.lane);
    }
    for (int m = gw; m < MT + BP * NMEM; m += NGW) {
        if (m < MP) row_to_bf16(in[0] + (size_t)m * DM, (bf16*)(F.ws + WS_XB) + (size_t)m * DM, F.lane);
        else if (m < MT) row_to_bf16(in[1] + (size_t)(m - MP) * DM, (bf16*)(F.ws + WS_XB) + (size_t)m * DM, F.lane);
        else row_to_bf16(in[8] + (size_t)(m - MT) * DM, (bf16*)(F.ws + WS_MEMB) + (size_t)(m - MT) * DM, F.lane);
    }
}

struct EpiProj0 {
    static constexpr bool PERM = true;
    bf16* UGH; bf16* US; bf16* PROJR;
    __device__ __forceinline__ void operator()(const pg8::f32x4 (&acc)[2][2][4][2], const pg8::Unit& u, int wr, int wc, int fr, int fq) const {
        const int row0 = u.pm * 256 + wr * 64 + fr, col0 = u.pn * 256 + wc * 32 + 8 * fq;
#pragma unroll
        for (int ai = 0; ai < 2; ++ai)
#pragma unroll
            for (int m = 0; m < 4; ++m) {
                const int row = row0 + ai * 128 + m * 16;
#pragma unroll
                for (int bj = 0; bj < 2; ++bj) {
                    const int col = col0 + bj * 128;
                    const pg8::f32x4 v0 = acc[ai][bj][m][0], v1 = acc[ai][bj][m][1];
                    pg8::u32x4 w; w.x = pg8::cvt_pk_bf16(v0[0], v0[1]); w.y = pg8::cvt_pk_bf16(v0[2], v0[3]); w.z = pg8::cvt_pk_bf16(v1[0], v1[1]); w.w = pg8::cvt_pk_bf16(v1[2], v1[3]);
                    bf16* dst;
                    if (u.pn < 3) {
                        if (u.pm < 64) { const int b = row >> 11, t = row & 2047, g = col >> 4;
                            dst = UGH + ((size_t)(g * 1024 + b * 128 + (t >> 4)) * UGK + (t & 15) * 16 + (col & 15)); }
                        else dst = US + (size_t)(row - MP) * MIX + col;
                    } else dst = PROJR + (size_t)row * PRW + (col - MIX);
                    *(pg8::u32x4*)dst = w;
                }
            }
    }
};
struct EpiMemKV {
    static constexpr bool PERM = false;
    float* out; bf16* MKVB;
    __device__ __forceinline__ void operator()(const pg8::f32x4 (&acc)[2][2][4][2], const pg8::Unit& u, int wr, int wc, int fr, int fq) const {
        const int row0 = u.pm * 256 + wr * 64 + fr, col0 = u.pn * 256 + wc * 32 + 4 * fq;
#pragma unroll
        for (int ai = 0; ai < 2; ++ai)
#pragma unroll
            for (int m = 0; m < 4; ++m) {
                const int row = row0 + ai * 128 + m * 16;
#pragma unroll
                for (int bj = 0; bj < 2; ++bj)
#pragma unroll
                    for (int n = 0; n < 2; ++n) {
                        const int col = col0 + bj * 128 + n * 16, l = col >> 9, k = col & 511;
                        const size_t idx = ((size_t)l * 2048 + row) * 512 + k;
                        const pg8::f32x4 v = acc[ai][bj][m][n];
                        *(pg8::f32x4*)(out + O_MEMKV + idx) = v;
                        pg8::u32x2 w; w.x = pg8::cvt_pk_bf16(v[0], v[1]); w.y = pg8::cvt_pk_bf16(v[2], v[3]);
                        *(pg8::u32x2*)(MKVB + idx) = w;
                    }
            }
    }
};
__device__ __forceinline__ float fast_sigmoid(float x) { return __builtin_amdgcn_rcpf(1.f + __builtin_amdgcn_exp2f(-1.4426950408889634f * x)); }
__device__ __forceinline__ float fast_silu(float x) { return x * fast_sigmoid(x); }
__device__ __forceinline__ float fast_gelu_tanh(float x) { const float z = 0.7978845608028654f * (x + 0.044715f * x * x * x); return x * fast_sigmoid(2.f * z); }
struct EpiS {
    static constexpr bool PERM = false;
    float* SST;
    __device__ __forceinline__ void operator()(const pg8::f32x4 (&acc)[2][2][4][2], const pg8::Unit& u, int wr, int wc, int fr, int fq) const {
        const int row0 = u.pm * 256 + wr * 64 + fr, col0 = wc * 32 + 4 * fq;
#pragma unroll
        for (int ai = 0; ai < 2; ++ai)
#pragma unroll
            for (int m = 0; m < 4; ++m) {
                const int row = row0 + ai * 128 + m * 16;
#pragma unroll
                for (int n = 0; n < 2; ++n) *(pg8::f32x4*)(SST + ((size_t)(u.gb * 1024 + row) * 128 + col0 + n * 16)) = acc[ai][0][m][n];
            }
    }
};
__device__ __forceinline__ void s5_carry_scan(const pg8::Unit& u, const float* SST, bf16* UGH, const float* TAB, float* out, int tid) {
    if (tid < 128) {
        const int bl = tid >> 6, p = tid & 63, g = u.gb, b = 2 * u.pm + bl;
        const float lr = TAB[TB_L16R + g * 64 + p], li = TAB[TB_L16I + g * 64 + p];
        float hr = 0.f, hi = 0.f;
        const float* s = SST + (size_t)(g * 1024 + b * 128) * 128 + p;
        bf16* h = UGH + (size_t)(g * 1024 + b * 128) * UGK + 256 + p;
#pragma unroll 8
        for (int k = 0; k < 128; ++k) {
            h[(size_t)k * UGK] = (bf16)f2bf(hr); h[(size_t)k * UGK + 64] = (bf16)f2bf(hi);
            const float sr = s[(size_t)k * 128], si = s[(size_t)k * 128 + 64];
            const float nr = lr * hr - li * hi + sr, ni = lr * hi + li * hr + si;
            hr = nr; hi = ni;
        }
        out[O_SRE_P + (size_t)(b * 48 + g) * 64 + p] = hr; out[O_SIM_P + (size_t)(b * 48 + g) * 64 + p] = hi;
    }
}
struct EpiY {
    static constexpr bool PERM = true;
    bf16* Y;
    __device__ __forceinline__ void operator()(const pg8::f32x4 (&acc)[2][2][4][2], const pg8::Unit& u, int wr, int wc, int fr, int fq) const {
        const int row0 = u.pm * 256 + wr * 64 + fr, col0 = wc * 32 + 8 * fq;
#pragma unroll
        for (int ai = 0; ai < 2; ++ai)
#pragma unroll
            for (int m = 0; m < 4; ++m) {
                const int R = row0 + ai * 128 + m * 16, b = R >> 7, k = R & 127;
#pragma unroll
                for (int bj = 0; bj < 2; ++bj) {
                    const int col = col0 + bj * 128, j = col >> 4, c0 = col & 15;
                    const pg8::f32x4 v0 = acc[ai][bj][m][0], v1 = acc[ai][bj][m][1];
                    pg8::u32x4 w;
                    w.x = pg8::cvt_pk_bf16(fast_gelu_tanh(v0[0]), fast_gelu_tanh(v0[1])); w.y = pg8::cvt_pk_bf16(fast_gelu_tanh(v0[2]), fast_gelu_tanh(v0[3]));
                    w.z = pg8::cvt_pk_bf16(fast_gelu_tanh(v1[0]), fast_gelu_tanh(v1[1])); w.w = pg8::cvt_pk_bf16(fast_gelu_tanh(v1[2]), fast_gelu_tanh(v1[3]));
                    *(pg8::u32x4*)(Y + ((size_t)(b * 2048 + k * 16 + j) * MIX + u.gb * 16 + c0)) = w;
                }
            }
    }
};
__device__ __forceinline__ void s5_sample_task(int b, int g, const float* const* in, const float* TAB, const bf16* US, bf16* Y, float* out, int lane) {
    const int gp = g * 64 + lane;
    const float lr = TAB[TB_LBR + gp], li = TAB[TB_LBI + gp];
    float br[16], bi[16], cr[16], ci[16];
#pragma unroll
    for (int q = 0; q < 4; ++q) { const f32x4 a = *(const f32x4*)(TAB + TB_BBR + gp * 16 + 4 * q), c = *(const f32x4*)(TAB + TB_BBI + gp * 16 + 4 * q);
        br[4 * q] = a.x; br[4 * q + 1] = a.y; br[4 * q + 2] = a.z; br[4 * q + 3] = a.w; bi[4 * q] = c.x; bi[4 * q + 1] = c.y; bi[4 * q + 2] = c.z; bi[4 * q + 3] = c.w; }
#pragma unroll
    for (int c = 0; c < 16; ++c) { cr[c] = in[19][(size_t)(g * 16 + c) * 64 + lane]; ci[c] = in[20][(size_t)(g * 16 + c) * 64 + lane]; }
    float hr = in[3][(size_t)(b * 48 + g) * 64 + lane], hi = in[4][(size_t)(b * 48 + g) * 64 + lane];
    float v[64];
#pragma unroll
    for (int t = 0; t < 4; ++t) {
        const bf16* up = US + (size_t)(b * 4 + t) * MIX + g * 16;
        const v4u u0 = *(const v4u*)up, u1 = *(const v4u*)(up + 8);
        float uu[16];
        uu[0] = pg8::bf_lo(u0.x); uu[1] = pg8::bf_hi(u0.x); uu[2] = pg8::bf_lo(u0.y); uu[3] = pg8::bf_hi(u0.y); uu[4] = pg8::bf_lo(u0.z); uu[5] = pg8::bf_hi(u0.z); uu[6] = pg8::bf_lo(u0.w); uu[7] = pg8::bf_hi(u0.w);
        uu[8] = pg8::bf_lo(u1.x); uu[9] = pg8::bf_hi(u1.x); uu[10] = pg8::bf_lo(u1.y); uu[11] = pg8::bf_hi(u1.y); uu[12] = pg8::bf_lo(u1.z); uu[13] = pg8::bf_hi(u1.z); uu[14] = pg8::bf_lo(u1.w); uu[15] = pg8::bf_hi(u1.w);
        float bur = 0.f, bui = 0.f;
#pragma unroll
        for (int c = 0; c < 16; ++c) { bur += br[c] * uu[c]; bui += bi[c] * uu[c]; }
        const float nr = lr * hr - li * hi + bur, ni = lr * hi + li * hr + bui;
        hr = nr; hi = ni;
#pragma unroll
        for (int c = 0; c < 16; ++c) v[t * 16 + c] = cr[c] * hr - ci[c] * hi;
    }
    out[O_SRE_S + (size_t)(b * 48 + g) * 64 + lane] = hr; out[O_SIM_S + (size_t)(b * 48 + g) * 64 + lane] = hi;
#define TR_STEP(N, MSK, SH) { const bool bit = (lane >> SH) & 1; _Pragma("unroll") for (int i = 0; i < N / 2; ++i) { const float send = bit ? v[i] : v[i + N / 2]; const float keep = bit ? v[i + N / 2] : v[i]; v[i] = keep + __shfl_xor(send, MSK); } }
    TR_STEP(64, 32, 5) TR_STEP(32, 16, 4) TR_STEP(16, 8, 3) TR_STEP(8, 4, 2) TR_STEP(4, 2, 1) TR_STEP(2, 1, 0)
#undef TR_STEP
    const int t = lane >> 4, c = lane & 15;
    const float uv = bf2f(US[(size_t)(b * 4 + t) * MIX + g * 16 + c]);
    const float y = v[0] + in[21][g * 16 + c] * uv;
    Y[(size_t)(MP + b * 4 + t) * MIX + g * 16 + c] = (bf16)f2bf(fast_gelu_tanh(y));
}
struct EpiGlu {
    static constexpr bool PERM = true;
    const bf16* Y; const bf16* PROJR; const float* b_glu; bf16* A1;
    __device__ __forceinline__ void operator()(const pg8::f32x4 (&acc)[2][2][4][2], const pg8::Unit& u, int wr, int wc, int fr, int fq) const {
        const int row0 = u.pm * 256 + wr * 64 + fr, col0 = u.pn * 256 + wc * 32 + 8 * fq;
#pragma unroll
        for (int bj = 0; bj < 2; ++bj) {
            const int col = col0 + bj * 128;
            const pg8::f32x4 b0 = *(const pg8::f32x4*)(b_glu + col), b1 = *(const pg8::f32x4*)(b_glu + col + 4);
#pragma unroll
            for (int ai = 0; ai < 2; ++ai)
#pragma unroll
                for (int m = 0; m < 4; ++m) {
                    const int row = row0 + ai * 128 + m * 16;
                    const pg8::u32x4 yv = *(const pg8::u32x4*)(Y + (size_t)row * MIX + col);
                    const pg8::u32x4 gv = *(const pg8::u32x4*)(PROJR + (size_t)row * PRW + col);
                    const pg8::f32x4 z0 = acc[ai][bj][m][0] + b0, z1 = acc[ai][bj][m][1] + b1;
                    float o[8];
                    o[0] = pg8::bf_lo(yv.x) * fast_sigmoid(z0[0]) * fast_silu(pg8::bf_lo(gv.x)); o[1] = pg8::bf_hi(yv.x) * fast_sigmoid(z0[1]) * fast_silu(pg8::bf_hi(gv.x));
                    o[2] = pg8::bf_lo(yv.y) * fast_sigmoid(z0[2]) * fast_silu(pg8::bf_lo(gv.y)); o[3] = pg8::bf_hi(yv.y) * fast_sigmoid(z0[3]) * fast_silu(pg8::bf_hi(gv.y));
                    o[4] = pg8::bf_lo(yv.z) * fast_sigmoid(z1[0]) * fast_silu(pg8::bf_lo(gv.z)); o[5] = pg8::bf_hi(yv.z) * fast_sigmoid(z1[1]) * fast_silu(pg8::bf_hi(gv.z));
                    o[6] = pg8::bf_lo(yv.w) * fast_sigmoid(z1[2]) * fast_silu(pg8::bf_lo(gv.w)); o[7] = pg8::bf_hi(yv.w) * fast_sigmoid(z1[3]) * fast_silu(pg8::bf_hi(gv.w));
                    pg8::u32x4 w; w.x = pg8::cvt_pk_bf16(o[0], o[1]); w.y = pg8::cvt_pk_bf16(o[2], o[3]); w.z = pg8::cvt_pk_bf16(o[4], o[5]); w.w = pg8::cvt_pk_bf16(o[6], o[7]);
                    *(pg8::u32x4*)(A1 + (size_t)row * DM + col) = w;
                }
        }
    }
};

typedef float f32x16 __attribute__((ext_vector_type(16)));
typedef short v4i16_t __attribute__((ext_vector_type(4)));
__device__ __forceinline__ f32x16 qk_tile(const bf16* krow, const bf16x8 (&qf)[4], int hh) {
    f32x16 acc = {};
#pragma unroll
    for (int ks = 0; ks < 4; ++ks) { const bf16x8 kf = *(const bf16x8*)(krow + 16 * ks + 8 * hh); acc = __builtin_amdgcn_mfma_f32_32x32x16_bf16(kf, qf[ks], acc, 0, 0, 0); }
    return acc;
}
template <class VRow> __device__ __forceinline__ void stage_v_tile(LAS unsigned char* vl, const VRow& vrow, int lane) {
    v4u tmp[4];
#pragma unroll
    for (int i = 0; i < 4; ++i) { const int piece = lane + 64 * i, key = piece >> 3, ch = piece & 7; tmp[i] = *(const v4u*)(vrow(key) + ch * 8); }
#pragma unroll
    for (int i = 0; i < 4; ++i) { const int piece = lane + 64 * i; *(LAS v4u*)(vl + piece * 16) = tmp[i]; }
}
__device__ __forceinline__ void pv_tile(f32x16 (&o)[2], const f32x16& p, const LAS unsigned char* vl, int lane) {
    const int hh = lane >> 5, gq = lane >> 4, q = (lane & 15) >> 2, pp = lane & 3;
    const LAS unsigned char* base = vl + (4 * hh + q) * 128 + (16 * (gq & 1) + 4 * pp) * 2;
#pragma unroll
    for (int s = 0; s < 2; ++s) {
        pg8::u32x4 pw; pw.x = pg8::cvt_pk_bf16(p[8 * s + 0], p[8 * s + 1]); pw.y = pg8::cvt_pk_bf16(p[8 * s + 2], p[8 * s + 3]);
        pw.z = pg8::cvt_pk_bf16(p[8 * s + 4], p[8 * s + 5]); pw.w = pg8::cvt_pk_bf16(p[8 * s + 6], p[8 * s + 7]);
        const bf16x8 pa = __builtin_bit_cast(bf16x8, pw);
#pragma unroll
        for (int db = 0; db < 2; ++db) {
            const v4i16_t lo = __builtin_amdgcn_ds_read_tr16_b64_v4i16((LAS v4i16_t*)(base + (16 * s) * 128 + db * 64));
            const v4i16_t hi = __builtin_amdgcn_ds_read_tr16_b64_v4i16((LAS v4i16_t*)(base + (16 * s + 8) * 128 + db * 64));
            const bf16x8 vf = (bf16x8){lo[0], lo[1], lo[2], lo[3], hi[0], hi[1], hi[2], hi[3]};
            o[db] = __builtin_amdgcn_mfma_f32_32x32x16_bf16(pa, vf, o[db], 0, 0, 0);
        }
    }
}
__device__ __forceinline__ float half_max(float v) { return fmaxf(v, __shfl_xor(v, 32)); }
__device__ __forceinline__ float half_sum(float v) { return v + __shfl_xor(v, 32); }

__device__ __forceinline__ void mem_attn_prompt_task(int b, int h, int qblk, const bf16* qbase, const bf16* gbase, int qpitch, const bf16* mkv  ,
                                                     bf16* A1, LAS unsigned char* vl, int lane) {
    const int qi = lane & 31, hh = lane >> 5;
    const size_t qrow = (size_t)b * SEQ + qblk * 32 + qi;
    bf16x8 qf[4];
#pragma unroll
    for (int ks = 0; ks < 4; ++ks) qf[ks] = *(const bf16x8*)(qbase + qrow * qpitch + h * 64 + 16 * ks + 8 * hh);
    float mx = -1e30f;
#pragma unroll 2
    for (int kt = 0; kt < 8; ++kt) {
        const f32x16 st = qk_tile(mkv + (size_t)(kt * 32 + qi) * 512 + h * 64, qf, hh);
#pragma unroll
        for (int r = 0; r < 16; ++r) mx = fmaxf(mx, st[r]);
    }
    mx = half_max(mx);
    const float c2 = 0.125f * 1.4426950408889634f;
    float l = 0.f;
    f32x16 o[2] = {};
#pragma unroll 1
    for (int kt = 0; kt < 8; ++kt) {
        f32x16 st = qk_tile(mkv + (size_t)(kt * 32 + qi) * 512 + h * 64, qf, hh);
#pragma unroll
        for (int r = 0; r < 16; ++r) { const float e = __builtin_amdgcn_exp2f((st[r] - mx) * c2); st[r] = e; l += e; }
        stage_v_tile(vl, [&](int key) { return mkv + (size_t)(kt * 32 + key) * 512 + 256 + h * 64; }, lane);
        LDS_WAIT();
        pv_tile(o, st, vl, lane);
        LDS_WAIT();
    }
    l = half_sum(l);
    const float il = 1.f / l;
#pragma unroll
    for (int r = 0; r < 16; ++r) {
        const int q = (r & 3) + 8 * (r >> 2) + 4 * hh;
        const float ilq = __shfl(il, q);
        const size_t row = (size_t)b * SEQ + qblk * 32 + q;
#pragma unroll
        for (int db = 0; db < 2; ++db) {
            const int d = db * 32 + qi;
            const float gate = bf2f(gbase[row * qpitch + h * 64 + d]);
            A1[row * DM + MIX + h * 64 + d] = (bf16)f2bf(o[db][r] * ilq * fast_silu(gate));
        }
    }
}
__device__ __forceinline__ void mem_attn_sample_task(int srow, int h, const bf16* qbase, const bf16* gbase, int qpitch, const float* cache_l  ,
                                                     bf16* A1, LAS float* scr, int lane) {
    const size_t row = (size_t)MP + srow;
    const float* kv = cache_l + (size_t)(srow / TS) * NMEM * 512;
    LAS float* qs = scr; LAS float* ps = scr + 64;
    qs[lane] = bf2f(qbase[row * qpitch + h * 64 + lane]);
    LDS_WAIT();
    float s[4]; float mx = -1e30f;
#pragma unroll
    for (int mm = 0; mm < 4; ++mm) {
        const float* k = kv + (size_t)(mm * 64 + lane) * 512 + h * 64;
        float a = 0.f;
#pragma unroll 4
        for (int e = 0; e < 64; e += 4) { const f32x4 kk = *(const f32x4*)(k + e); a += qs[e] * kk.x + qs[e + 1] * kk.y + qs[e + 2] * kk.z + qs[e + 3] * kk.w; }
        s[mm] = a * 0.125f; mx = fmaxf(mx, s[mm]);
    }
    mx = wave_max(mx);
    float sum = 0.f;
#pragma unroll
    for (int mm = 0; mm < 4; ++mm) { s[mm] = __expf(s[mm] - mx); sum += s[mm]; }
    sum = wave_sum(sum);
    const float inv = 1.f / sum;
#pragma unroll
    for (int mm = 0; mm < 4; ++mm) ps[mm * 64 + lane] = s[mm] * inv;
    LDS_WAIT();
    float o = 0.f;
#pragma unroll 8
    for (int m = 0; m < NMEM; ++m) o += ps[m] * kv[(size_t)m * 512 + 256 + h * 64 + lane];
    const float gate = bf2f(gbase[row * qpitch + h * 64 + lane]);
    A1[row * DM + MIX + h * 64 + lane] = (bf16)f2bf(o * fast_silu(gate));
    LDS_WAIT();
}
__device__ __forceinline__ void mem_attn_phase(Frame& F, int layer, const bf16* qbase, const bf16* gbase, int qpitch, const float* cache_mem, bf16* A1) {
    const int gw = F.vcu * NWAVES + F.wave, NGW = F.G * NWAVES;
    const int lane = opaque_i(F.lane);
    LAS unsigned char* wl = F.lds + RING_OFF + F.wave * 16384;
    const bf16* mkvb = (const bf16*)(F.ws + WS_MKVB) + (size_t)layer * BP * NMEM * 512;
    constexpr int NT_P = BP * 4 * (SEQ / 32);
    constexpr int NT_S = MS * 4;
    for (int t = gw; t < NT_P + NT_S; t += NGW) {
        if (t < NT_P) { const int qblk = t % (SEQ / 32), bh = t / (SEQ / 32), h = bh & 3, b = bh >> 2;
            mem_attn_prompt_task(b, h, qblk, qbase, gbase, qpitch, mkvb + (size_t)b * NMEM * 512, A1, wl, lane); }
        else { const int ts = t - NT_P; mem_attn_sample_task(ts >> 2, ts & 3, qbase, gbase, qpitch, cache_mem + (size_t)layer * BS * NMEM * 512, A1, (LAS float*)(wl + 8192), lane); }
    }
}
struct EpiR {
    static constexpr bool PERM = false;
    const float* xa; const float* xb; float* R;
    __device__ __forceinline__ void operator()(const pg8::f32x4 (&acc)[2][2][4][2], const pg8::Unit& u, int wr, int wc, int fr, int fq) const {
        const int row0 = u.pm * 256 + wr * 64 + fr, col0 = u.pn * 256 + wc * 32 + 4 * fq;
        const float* xs = u.pm < 64 ? xa + (size_t)row0 * DM : xb + (size_t)(row0 - MP) * DM;
#pragma unroll
        for (int ai = 0; ai < 2; ++ai)
#pragma unroll
            for (int m = 0; m < 4; ++m) {
                const size_t ro = (size_t)(ai * 128 + m * 16) * DM;
#pragma unroll
                for (int bj = 0; bj < 2; ++bj)
#pragma unroll
                    for (int n = 0; n < 2; ++n) {
                        const int col = col0 + bj * 128 + n * 16;
                        const pg8::f32x4 xv = *(const pg8::f32x4*)(xs + ro + col);
                        *(pg8::f32x4*)(R + (size_t)row0 * DM + ro + col) = xv * ALPHA + acc[ai][bj][m][n];
                    }
            }
    }
};
__device__ __forceinline__ void ln_phase(Frame& F, const float* R, const float* gam, const float* bet, float* o32, bf16* ob) {
    const int gw = F.vcu * NWAVES + F.wave, NGW = F.G * NWAVES;
    const int lane_ = opaque_i(F.lane);
    f32x4 gv[4], bv[4];
#pragma unroll
    for (int j = 0; j < 4; ++j) { gv[j] = *((const f32x4*)gam + lane_ + 64 * j); bv[j] = *((const f32x4*)bet + lane_ + 64 * j); }
    for (int m = gw; m < MT; m += NGW) {
        const f32x4* xr = (const f32x4*)(R + (size_t)m * DM) + lane_;
        f32x4 v[4]; float s = 0.f;
#pragma unroll
        for (int j = 0; j < 4; ++j) { v[j] = xr[64 * j]; s += (v[j].x + v[j].y) + (v[j].z + v[j].w); }
        const float mean = wave_sum(s) * (1.f / DM); float s2 = 0.f;
#pragma unroll
        for (int j = 0; j < 4; ++j) { v[j] = v[j] - mean; s2 += (v[j].x * v[j].x + v[j].y * v[j].y) + (v[j].z * v[j].z + v[j].w * v[j].w); }
        const float rstd = 1.f / sqrtf(wave_sum(s2) * (1.f / DM) + LN_EPS);
#pragma unroll
        for (int j = 0; j < 4; ++j) {
            const f32x4 o = v[j] * rstd * gv[j] + bv[j];
            *((f32x4*)(o32 + (size_t)m * DM) + lane_ + 64 * j) = o;
            if (ob) { v2u w; w.x = pk2(o.x, o.y); w.y = pk2(o.z, o.w); *((v2u*)(ob + (size_t)m * DM) + lane_ + 64 * j) = w; }
        }
    }
}
struct EpiKVQ {
    static constexpr bool PERM = true;
    bf16* KVP; float* out;
    __device__ __forceinline__ void operator()(const pg8::f32x4 (&acc)[2][2][4][2], const pg8::Unit& u, int wr, int wc, int fr, int fq) const {
        const int row0 = u.pm * 256 + wr * 64 + fr, colt = wc * 32 + 8 * fq;
        const bool iskv = u.pn < 6;
        const int s = u.pn >= 3 ? 1 : 0, g = u.pn - 3 * s;
        const int win = g == 0 ? 128 : (g == 1 ? 512 : 2048);
        const size_t obase_p = g == 0 ? O_D1P : (g == 1 ? O_D4P : O_D16P), obase_s = g == 0 ? O_D1S : (g == 1 ? O_D4S : O_D16S);
#pragma unroll
        for (int ai = 0; ai < 2; ++ai)
#pragma unroll
            for (int m = 0; m < 4; ++m) {
                const int row = row0 + ai * 128 + m * 16;
#pragma unroll
                for (int bj = 0; bj < 2; ++bj) {
                    const int ct = colt + bj * 128;
                    const pg8::f32x4 v0 = acc[ai][bj][m][0], v1 = acc[ai][bj][m][1];
                    pg8::u32x4 w; w.x = pg8::cvt_pk_bf16(v0[0], v0[1]); w.y = pg8::cvt_pk_bf16(v0[2], v0[3]); w.z = pg8::cvt_pk_bf16(v1[0], v1[1]); w.w = pg8::cvt_pk_bf16(v1[2], v1[3]);
                    *(pg8::u32x4*)(KVP + (size_t)row * KVW + u.pn * 256 + ct) = w;
                    if (iskv) {
                        float* dst = nullptr;
                        if (u.pm < 64) { const int b = row >> 11, t = row & 2047;
                            if (t >= SEQ - win) dst = out + obase_p + ((size_t)(b * win + (t - (SEQ - win))) * 2 + s) * 256 + ct; }
                        else { const int rs = row - MP, b = rs >> 2, t = rs & 3;
                            dst = out + obase_s + ((size_t)(b * win + (win - 4 + t)) * 2 + s) * 256 + ct; }
                        if (dst) { *(pg8::f32x4*)dst = v0; *(pg8::f32x4*)(dst + 4) = v1; }
                    }
                }
            }
    }
};
__device__ __forceinline__ void dil_attn_prompt_task(int b, int h, int x, const bf16* KVP, bf16* ATT, float* LSE, LAS unsigned char* vl, int lane) {
    const int qi = lane & 31, hh = lane >> 5, g = h >> 2;
    const int dil = g == 0 ? 1 : (g == 1 ? 4 : 16), nb = (SEQ / 32) / dil;
    const int r = x / nb, i0 = (x % nb) * 32;
    const float slope2 = __builtin_amdgcn_exp2f(-8.0f * (float)(h + 1) / 12.0f) * (float)dil * 1.4426950408889634f;
    const float c2 = 0.125f * 1.4426950408889634f;
    const bf16* base = KVP + (size_t)b * SEQ * KVW + h * 64;
    const size_t qrow = (size_t)(r + dil * (i0 + qi)) * KVW;
    bf16x8 qf[4];
#pragma unroll
    for (int ks = 0; ks < 4; ++ks) qf[ks] = *(const bf16x8*)(base + qrow + 1536 + 16 * ks + 8 * hh);
    const int kt0 = i0 >= 128 ? 0 : (128 - i0) / 32;
    float mx = -1e30f;
#pragma unroll 1
    for (int kt = kt0; kt < 5; ++kt) {
        int ik = i0 - 128 + 32 * kt + qi; ik = ik < 0 ? 0 : ik;
        const f32x16 st = qk_tile(base + (size_t)(r + dil * ik) * KVW, qf, hh);
#pragma unroll
        for (int rr = 0; rr < 16; ++rr) {
            const int kk = (rr & 3) + 8 * (rr >> 2) + 4 * hh, m = qi + 128 - 32 * kt - kk;
            const bool ok = m >= 0 && m <= 128 && (i0 - 128 + 32 * kt + kk) >= 0;
            const float s2 = st[rr] * c2 - slope2 * (float)m;
            mx = ok ? fmaxf(mx, s2) : mx;
        }
    }
    mx = half_max(mx);
    float l = 0.f;
    f32x16 o[2] = {};
#pragma unroll 1
    for (int kt = kt0; kt < 5; ++kt) {
        int ik = i0 - 128 + 32 * kt + qi; ik = ik < 0 ? 0 : ik;
        f32x16 st = qk_tile(base + (size_t)(r + dil * ik) * KVW, qf, hh);
#pragma unroll
        for (int rr = 0; rr < 16; ++rr) {
            const int kk = (rr & 3) + 8 * (rr >> 2) + 4 * hh, m = qi + 128 - 32 * kt - kk;
            const bool ok = m >= 0 && m <= 128 && (i0 - 128 + 32 * kt + kk) >= 0;
            const float e = ok ? __builtin_amdgcn_exp2f(st[rr] * c2 - slope2 * (float)m - mx) : 0.f;
            st[rr] = e; l += e;
        }
        const int ikb = i0 - 128 + 32 * kt;
        stage_v_tile(vl, [&](int key) { int i = ikb + key; i = i < 0 ? 0 : i; return base + (size_t)(r + dil * i) * KVW + 768; }, lane);
        LDS_WAIT();
        pv_tile(o, st, vl, lane);
        LDS_WAIT();
    }
    l = half_sum(l);
    const float il = 1.f / l;
    if (hh == 0) LSE[((size_t)b * SEQ + r + dil * (i0 + qi)) * NH + h] = mx + __builtin_amdgcn_logf(l);
#pragma unroll
    for (int rr = 0; rr < 16; ++rr) {
        const int q = (rr & 3) + 8 * (rr >> 2) + 4 * hh;
        const float ilq = __shfl(il, q);
        const size_t row = (size_t)b * SEQ + r + dil * (i0 + q);
#pragma unroll
        for (int db = 0; db < 2; ++db) ATT[row * MIX + h * 64 + db * 32 + qi] = (bf16)f2bf(o[db][rr] * ilq);
    }
}
__device__ __forceinline__ void dil_attn_sample_task(int srow, int h, const bf16* KVP, const float* buf1, const float* buf4, const float* buf16, bf16* ATT, float* LSE, LAS float* scr, int lane) {
    const int g = h >> 2, hq = h & 3;
    const int dil = g == 0 ? 1 : (g == 1 ? 4 : 16), Lb = g == 0 ? 128 : (g == 1 ? 512 : 2048);
    const float* buf = g == 0 ? buf1 : (g == 1 ? buf4 : buf16);
    const float slope = __builtin_amdgcn_exp2f(-8.0f * (float)(h + 1) / 12.0f);
    const int b = srow >> 2, t = srow & 3;
    const size_t row = (size_t)MP + srow;
    LAS float* qs = scr; LAS float* ps = scr + 64;
    qs[lane] = bf2f(KVP[row * KVW + 1536 + h * 64 + lane]);
    LDS_WAIT();
    float s[3]; float mx = -1e30f;
#pragma unroll
    for (int mm = 0; mm < 3; ++mm) {
        const int m = mm * 64 + lane;
        s[mm] = -1e30f;
        if (m <= 128) {
            const int idx = Lb + t - m * dil;
            float a = 0.f;
            if (idx < Lb) { const float* kp = buf + ((size_t)b * Lb + idx) * 512 + hq * 64;
#pragma unroll 4
                for (int e = 0; e < 64; e += 4) { const f32x4 kk = *(const f32x4*)(kp + e); a += qs[e] * kk.x + qs[e + 1] * kk.y + qs[e + 2] * kk.z + qs[e + 3] * kk.w; } }
            else { const bf16* kp = KVP + ((size_t)MP + b * 4 + (idx - Lb)) * KVW + h * 64;
#pragma unroll 4
                for (int e = 0; e < 64; e += 2) { const unsigned w = *(const unsigned*)(kp + e); a += qs[e] * pg8::bf_lo(w) + qs[e + 1] * pg8::bf_hi(w); } }
            s[mm] = a * 0.125f - slope * (float)(m * dil);
        }
        mx = fmaxf(mx, s[mm]);
    }
    mx = wave_max(mx);
    float sum = 0.f;
#pragma unroll
    for (int mm = 0; mm < 3; ++mm) { const int m = mm * 64 + lane; s[mm] = m <= 128 ? __expf(s[mm] - mx) : 0.f; sum += s[mm]; }
    sum = wave_sum(sum);
    const float inv = 1.f / sum;
#pragma unroll
    for (int mm = 0; mm < 3; ++mm) { const int m = mm * 64 + lane; if (m <= 128) ps[m] = s[mm] * inv; }
    LDS_WAIT();
    float o = 0.f;
#pragma unroll 4
    for (int m = 0; m <= 128; ++m) {
        const int idx = Lb + t - m * dil;
        const float v = idx < Lb ? buf[((size_t)b * Lb + idx) * 512 + 256 + hq * 64 + lane] : bf2f(KVP[((size_t)MP + b * 4 + (idx - Lb)) * KVW + 768 + h * 64 + lane]);
        o += ps[m] * v;
    }
    ATT[row * MIX + h * 64 + lane] = (bf16)f2bf(o);
    if (lane == 0) LSE[row * NH + h] = (mx + __logf(sum)) * 1.4426950408889634f;
    LDS_WAIT();
}
__device__ __forceinline__ void dil_attn_phase(Frame& F, const float* const* in) {
    const int gw = F.vcu * NWAVES + F.wave, NGW = F.G * NWAVES;
    const int lane = opaque_i(F.lane);
    LAS unsigned char* wl = F.lds + RING_OFF + F.wave * 16384;
    const bf16* KVP = (const bf16*)(F.ws + WS_KVP); bf16* ATT = (bf16*)(F.ws + WS_ATT); float* LSE = (float*)(F.ws + WS_LSE);
    constexpr int NT_P = BP * NH * (SEQ / 32);
    constexpr int NT_S = MS * NH;
    for (int t = gw; t < NT_P + NT_S; t += NGW) {
        if (t < NT_P) { const int x = t % (SEQ / 32), bh = t / (SEQ / 32), h = bh % NH, b = bh / NH; dil_attn_prompt_task(b, h, x, KVP, ATT, LSE, wl, lane); }
        else { const int ts = t - NT_P; dil_attn_sample_task(ts / NH, ts % NH, KVP, in[5], in[6], in[7], ATT, LSE, (LAS float*)(wl + 8192), lane); }
    }
}
__device__ __forceinline__ void merge_gate_phase(Frame& F) {
    const bf16* KVP = (const bf16*)(F.ws + WS_KVP); const bf16* ATT = (const bf16*)(F.ws + WS_ATT); const float* LSE = (const float*)(F.ws + WS_LSE); bf16* A1 = (bf16*)(F.ws + WS_A1);
    const size_t gt = (size_t)F.vcu * NWAVES * 64 + opaque_i(F.tid), nth = (size_t)F.G * NWAVES * 64;
    for (size_t i = gt; i < (size_t)MT * (MIX / 8); i += nth) {
        const size_t row = i / (MIX / 8); const int c = (int)(i % (MIX / 8)) * 8, h = c >> 6, j = h & 3;
        const float l0 = LSE[row * NH + j], l1 = LSE[row * NH + 4 + j], l2 = LSE[row * NH + 8 + j];
        const float mx = fmaxf(l0, fmaxf(l1, l2));
        const float den = __builtin_amdgcn_exp2f(l0 - mx) + __builtin_amdgcn_exp2f(l1 - mx) + __builtin_amdgcn_exp2f(l2 - mx);
        const float w = __builtin_amdgcn_exp2f(LSE[row * NH + h] - mx) / den;
        const v4u av = *(const v4u*)(ATT + row * MIX + c), gv = *(const v4u*)(KVP + row * KVW + 2304 + c);
        v4u o;
        o.x = pk2(pg8::bf_lo(av.x) * w * fast_silu(pg8::bf_lo(gv.x)), pg8::bf_hi(av.x) * w * fast_silu(pg8::bf_hi(gv.x)));
        o.y = pk2(pg8::bf_lo(av.y) * w * fast_silu(pg8::bf_lo(gv.y)), pg8::bf_hi(av.y) * w * fast_silu(pg8::bf_hi(gv.y)));
        o.z = pk2(pg8::bf_lo(av.z) * w * fast_silu(pg8::bf_lo(gv.z)), pg8::bf_hi(av.z) * w * fast_silu(pg8::bf_hi(gv.z)));
        o.w = pk2(pg8::bf_lo(av.w) * w * fast_silu(pg8::bf_lo(gv.w)), pg8::bf_hi(av.w) * w * fast_silu(pg8::bf_hi(gv.w)));
        *(v4u*)(A1 + row * DM + c) = o;
    }
}
struct Args { const float* in[25]; float* out; unsigned char* ws; int ph_lo, ph_hi; };
__global__ void __launch_bounds__(NWAVES * 64, 2) fwd(Args args) {
    extern __shared__ __attribute__((aligned(16))) unsigned char lds[];
    Frame F;
    F.lds = (LAS unsigned char*)lds;
    F.MISC = (volatile LAS unsigned*)(F.lds + MISC_OFF);
    F.tid = threadIdx.x; F.lane = F.tid & 63; F.wave = __builtin_amdgcn_readfirstlane(F.tid >> 6);
    F.G = gridDim.x; { const int bx = blockIdx.x; F.vcu = (F.G % 8 == 0) ? (bx % 8) * (F.G / 8) + bx / 8 : bx; }
    F.ws = args.ws; F.out = args.out;
    F.ctl = (gu32*)(F.ws + WS_CTL);
    for (int u = F.tid; u < (LDS_BYTES - LDSCTL_OFF) / 4; u += NWAVES * 64) ((LAS unsigned*)(F.lds + LDSCTL_OFF))[u] = 0u;
    __syncthreads();
    XcdBarrier bar = xcd_barrier_post((unsigned*)(F.ctl + CW_BAR), F.MISC + 8);
    const int lo = args.ph_lo, hi = args.ph_hi;
#define IN(k) (lo <= (k) && (k) < hi)
#define BOTH(k) (IN(k) && IN((k) + 1))
    if (IN(0)) { p0_prologue(F, args.in);
        { const int gt = F.vcu * NWAVES * 64 + F.tid, nth = F.G * NWAVES * 64;
          copy_cache(args.in[5], F.out + O_D1S, 128, gt, nth); copy_cache(args.in[6], F.out + O_D4S, 512, gt, nth); copy_cache(args.in[7], F.out + O_D16S, 2048, gt, nth); }
 if (BOTH(0)) xcd_barrier(bar); }
    if (IN(1)) {
        {
            pg8::Gemm g{(const bf16*)(F.ws + WS_XB), (const bf16*)(F.ws + WS_WIN0), 1024, 1024, 1024, 0, 0};
            pg8::StaticOrder S; S.init(MT, INW, F.G, (int)blockIdx.x);
            EpiProj0 E{(bf16*)(F.ws + WS_UGH), (bf16*)(F.ws + WS_US), (bf16*)(F.ws + WS_PROJR)};
            pg8::gemm_phase<EpiProj0, pg8::StaticOrder, true>(F.lds + RING_OFF, g, S, E);
        }
        {
            pg8::Gemm g{(const bf16*)(F.ws + WS_MEMB), (const bf16*)(F.ws + WS_WMEM), 1024, 1024, 1024, 0, 0};
            pg8::StaticOrder S; S.init(BP * NMEM, 1024, F.G, (int)((blockIdx.x + 192u) % (unsigned)F.G));
            EpiMemKV E{F.out, (bf16*)(F.ws + WS_MKVB)};
            pg8::gemm_phase<EpiMemKV, pg8::StaticOrder, true>(F.lds + RING_OFF, g, S, E);
        }
        if (BOTH(1)) xcd_barrier(bar);
    }
    if (IN(2)) {
        pg8::Gemm g{(const bf16*)(F.ws + WS_UGH), (const bf16*)(F.ws + WS_PT), UGK, 256, 256, (size_t)1024 * UGK, (size_t)256 * 256};
        pg8::BatchOrder S; S.init(NG, 4, F.G, (int)blockIdx.x);
        EpiS E{(float*)(F.ws + WS_SST)};
        pg8::gemm_phase<EpiS, pg8::BatchOrder, true>(F.lds + RING_OFF, g, S, E);
        if (BOTH(2)) xcd_barrier(bar);
    }
    if (IN(3)) {
        pg8::Gemm g{(const bf16*)(F.ws + WS_UGH), (const bf16*)(F.ws + WS_TQ), UGK, UGK, UGK, (size_t)1024 * UGK, (size_t)256 * UGK};
        pg8::BatchOrder S; S.init(NG, 4, F.G, (int)blockIdx.x);
        { pg8::Unit u; for (int i = 0; S.next(i, u); ++i) s5_carry_scan(u, (const float*)(F.ws + WS_SST), (bf16*)(F.ws + WS_UGH), (const float*)(F.ws + WS_TAB), F.out, F.tid); }
        VM_WAIT(); __syncthreads();
        EpiY E{(bf16*)(F.ws + WS_Y)};
        pg8::gemm_phase<EpiY, pg8::BatchOrder, true>(F.lds + RING_OFF, g, S, E);
        if ((int)blockIdx.x >= NG * 4) {
            const int nw = (F.G - NG * 4) * NWAVES;
            for (int task = ((int)blockIdx.x - NG * 4) * NWAVES + F.wave; task < BS * NG; task += nw)
                s5_sample_task(task / NG, task % NG, args.in, (const float*)(F.ws + WS_TAB), (const bf16*)(F.ws + WS_US), (bf16*)(F.ws + WS_Y), F.out, F.lane);
        }
        if (BOTH(3)) xcd_barrier(bar);
    }
    if (IN(4)) {
        pg8::Gemm g{(const bf16*)(F.ws + WS_Y), (const bf16*)(F.ws + WS_WGLU), MIX, MIX, MIX, 0, 0};
        pg8::StaticOrder S; S.init(MT, MIX, F.G, (int)blockIdx.x);
        EpiGlu E{(const bf16*)(F.ws + WS_Y), (const bf16*)(F.ws + WS_PROJR), args.in[23], (bf16*)(F.ws + WS_A1)};
        pg8::gemm_phase<EpiGlu, pg8::StaticOrder, true>(F.lds + RING_OFF, g, S, E);
        mem_attn_phase(F, 0, (const bf16*)(F.ws + WS_PROJR) + MIX, (const bf16*)(F.ws + WS_PROJR) + MIX + 256, PRW, args.in[2], (bf16*)(F.ws + WS_A1));
        if (BOTH(4)) xcd_barrier(bar);
    }
    if (IN(5)) {
        pg8::Gemm g{(const bf16*)(F.ws + WS_A1), (const bf16*)(F.ws + WS_WOUT0), DM, DM, DM, 0, 0};
        pg8::StaticOrder S; S.init(MT, DM, F.G, (int)blockIdx.x);
        EpiR E{args.in[0], args.in[1], (float*)(F.ws + WS_R)};
        pg8::gemm_phase<EpiR, pg8::StaticOrder, true>(F.lds + RING_OFF, g, S, E);
        if (BOTH(5)) xcd_barrier(bar);
    }
    if (IN(6)) {
        ln_phase(F, (const float*)(F.ws + WS_R), args.in[11], args.in[12], (float*)(F.ws + WS_X1), (bf16*)(F.ws + WS_X1B));
        if (BOTH(6)) xcd_barrier(bar);
    }
    if (IN(7)) {
        pg8::Gemm g{(const bf16*)(F.ws + WS_X1B), (const bf16*)(F.ws + WS_WB1), DM, DM, DM, 0, 0};
        pg8::StaticOrder S; S.init(MT, KVW, F.G, (int)blockIdx.x);
        EpiKVQ E{(bf16*)(F.ws + WS_KVP), F.out};
        pg8::gemm_phase<EpiKVQ, pg8::StaticOrder, true>(F.lds + RING_OFF, g, S, E);
        if (BOTH(7)) xcd_barrier(bar);
    }
    if (IN(8)) {
        dil_attn_phase(F, args.in);
        mem_attn_phase(F, 1, (const bf16*)(F.ws + WS_KVP) + 3072, (const bf16*)(F.ws + WS_KVP) + 3328, KVW, args.in[2], (bf16*)(F.ws + WS_A1));
        if (BOTH(8)) xcd_barrier(bar);
    }
    if (IN(9)) { merge_gate_phase(F); if (BOTH(9)) xcd_barrier(bar); }
    if (IN(10)) {
        pg8::Gemm g{(const bf16*)(F.ws + WS_A1), (const bf16*)(F.ws + WS_WOUT1), DM, DM, DM, 0, 0};
        pg8::StaticOrder S; S.init(MT, DM, F.G, (int)blockIdx.x);
        EpiR E{(const float*)(F.ws + WS_X1), (const float*)(F.ws + WS_X1) + (size_t)MP * DM, (float*)(F.ws + WS_R)};
        pg8::gemm_phase<EpiR, pg8::StaticOrder, true>(F.lds + RING_OFF, g, S, E);
        if (BOTH(10)) xcd_barrier(bar);
    }
    if (IN(11)) { ln_phase(F, (const float*)(F.ws + WS_R), args.in[11] + DM, args.in[12] + DM, F.out + O_Y, nullptr); }
#undef IN
#undef BOTH
}

__global__ void cvt_proj0(const bf16* UGH, const bf16* US, const bf16* PROJR, float* PROJ) {
    const size_t i = (size_t)blockIdx.x * blockDim.x + threadIdx.x;
    if (i >= (size_t)MT * INW) return;
    const int row = (int)(i / INW), col = (int)(i % INW);
    bf16 v;
    if (col < MIX) {
        if (row < MP) { const int b = row >> 11, t = row & 2047, g = col >> 4; v = UGH[(size_t)(g * 1024 + b * 128 + (t >> 4)) * UGK + (t & 15) * 16 + (col & 15)]; }
        else v = US[(size_t)(row - MP) * MIX + col];
    } else v = PROJR[(size_t)row * PRW + (col - MIX)];
    PROJ[i] = bf2f(v);
}

__global__ void cvt_bf16_f32(const bf16* src, float* dst, size_t n) {
    const size_t i = (size_t)blockIdx.x * blockDim.x + threadIdx.x;
    if (i < n) dst[i] = bf2f(src[i]);
}
__global__ void cvt_kvp(const bf16* KVP, float* KV, float* PROJ) {
    const size_t i = (size_t)blockIdx.x * blockDim.x + threadIdx.x;
    if (i >= (size_t)MT * KVW) return;
    const size_t row = i / KVW; const int col = (int)(i % KVW);
    const float v = bf2f(KVP[i]);
    if (col < 1536) KV[row * 1536 + col] = v; else PROJ[row * 2048 + (col - 1536)] = v;
}
extern "C" void kernel_launch(void* const* d_in, const int* in_sizes, int n_in, void* d_out, int out_size, void* d_ws, size_t ws_size, hipStream_t stream) {
    static int grid = 0;
    if (grid == 0) {
        int dev = 0, cus = 0, per_cu = 0;
        if (hipGetDevice(&dev) != hipSuccess || hipDeviceGetAttribute(&cus, hipDeviceAttributeMultiprocessorCount, dev) != hipSuccess) { fprintf(stderr, "kernel_launch: device query failed\n"); grid = -1; return; }
        if (hipFuncSetAttribute((const void*)fwd, hipFuncAttributeMaxDynamicSharedMemorySize, LDS_BYTES) != hipSuccess) { fprintf(stderr, "kernel_launch: hipFuncSetAttribute failed\n"); grid = -1; return; }
        if (hipOccupancyMaxActiveBlocksPerMultiprocessor(&per_cu, (const void*)fwd, NWAVES * 64, LDS_BYTES) != hipSuccess || per_cu < 1) { fprintf(stderr, "kernel_launch: occupancy query says %d\n", per_cu); per_cu = 1; }
        (void)hipGetLastError();
        grid = cus * 1;
        if (per_cu != 1) fprintf(stderr, "kernel_launch: note: occupancy query reports %d blocks/CU\n", per_cu);
    }
    if (grid < 0) return;
    hipMemsetAsync((char*)d_ws + WS_CTL, 0, CTL_ZERO_BYTES, stream);
    Args a{};
    for (int i = 0; i < 25; ++i) a.in[i] = (const float*)d_in[i];
    a.out = (float*)d_out; a.ws = (unsigned char*)d_ws; a.ph_lo = 0; a.ph_hi = 12;
    void* kargs[] = {&a};
    hipError_t e = hipLaunchCooperativeKernel((const void*)fwd, dim3(grid), dim3(NWAVES * 64), kargs, LDS_BYTES, stream);
    if (e != hipSuccess) fprintf(stderr, "kernel_launch: cooperative launch failed: %s\n", hipGetErrorString(e));

}
```

```cpp
#include <hip/hip_runtime.h>
#include <cstdio>
#include <cstdint>
#include <math.h>
namespace pg8 {
#define PG8_LAS __attribute__((address_space(3)))
typedef unsigned short bf16_t;
typedef short bf16x8 __attribute__((ext_vector_type(8)));
typedef float f32x4 __attribute__((ext_vector_type(4)));
typedef float f32x2 __attribute__((ext_vector_type(2)));
typedef unsigned u32x4 __attribute__((ext_vector_type(4)));
typedef unsigned u32x2 __attribute__((ext_vector_type(2)));
constexpr int BM = 256, BK = 64, HALF = 128, HTB = HALF * BK * 2, STAGE_BYTES = 8 * HTB, NXCD = 8, WGM = 8;

__host__ __device__ __forceinline__ int lds_byte(int r, int c) { const int st = (r >> 4) * 2 + (c >> 5), rr = r & 15, cc = c & 31, ob = rr * 64 + cc * 2; return st * 1024 + (ob ^ (((ob >> 9) & 1) << 5)); }
__host__ __device__ __forceinline__ void stage_rc(int b, int& R, int& C) { const int st = b / 1024, sb = b % 1024, swz = sb ^ (((sb >> 9) & 1) << 5); R = (st >> 1) * 16 + swz / 64; C = (st & 1) * 32 + (swz % 64) / 2; }
__host__ __device__ __forceinline__ int perm32(int rho) { const int n = rho >> 4, i = rho & 15; return 8 * (i >> 2) + 4 * n + (i & 3); }

struct Unit { int pm, pn, gb; };
struct Gemm { const bf16_t* A; const bf16_t* Bt; int lda, ldb, K; size_t bsA, bsB; };

struct StaticOrder {
    int nM, nN, nwg, G, c;
    __device__ __forceinline__ void init(int M, int N, int G_, int c_) { nM = M / BM; nN = N / BM; nwg = nM * nN; G = G_; c = c_; }
    __device__ __forceinline__ bool next(int i, Unit& u) const {
        const long L = (long)i * G + c; if (L >= nwg) return false;
        int wgid = (int)L; { const int q = nwg / NXCD, r = nwg % NXCD, xcd = wgid % NXCD, off = wgid / NXCD; wgid = (xcd < r ? xcd * (q + 1) : r * (q + 1) + (xcd - r) * q) + off; }
        const int nig = WGM * nN, gid = wgid / nig, fm = gid * WGM, gsz = (nM - fm) < WGM ? (nM - fm) : WGM;
        u.pm = fm + ((wgid % nig) % gsz); u.pn = (wgid % nig) / gsz; u.gb = 0; return true;
    }
};
struct BatchOrder {
    int nM, nwg, G, c;
    __device__ __forceinline__ void init(int nB, int nM_, int G_, int c_) { nM = nM_; nwg = nB * nM_; G = G_; c = c_; }
    __device__ __forceinline__ bool next(int i, Unit& u) const { const long L = (long)i * G + c; if (L >= nwg) return false; u.gb = (int)L / nM; u.pm = (int)L % nM; u.pn = 0; return true; }
};

__device__ __forceinline__ unsigned cvt_pk_bf16(float lo, float hi) { unsigned r; asm volatile("v_cvt_pk_bf16_f32 %0, %1, %2" : "=v"(r) : "v"(lo), "v"(hi)); return r; }
__device__ __forceinline__ float bf_lo(unsigned w) { return __uint_as_float(w << 16); }
__device__ __forceinline__ float bf_hi(unsigned w) { return __uint_as_float(w & 0xffff0000u); }

template <class Epi, class Sched, bool ALIGN_EPI>
__device__ __forceinline__ void gemm_phase(PG8_LAS unsigned char* lds, const Gemm g, const Sched& S, const Epi& E, const int wid  ) {
    int lane_ = (int)__builtin_amdgcn_mbcnt_hi(~0u, __builtin_amdgcn_mbcnt_lo(~0u, 0u)); asm volatile("" : "+v"(lane_));
    const int lane = lane_, tid = wid * 64 + lane, wr = wid >> 2, wc = wid & 3, fr = lane & 15, fq = lane >> 4;
    const int K = g.K, nt = K / BK;
    unsigned voffA[2], voffB[2];
#pragma unroll
    for (int i = 0; i < 2; ++i) { int R, C; stage_rc(tid * 16 + i * 8192, R, C); const int Rb = Epi::PERM ? ((R & ~31) + perm32(R & 31)) : R;
        voffA[i] = (unsigned)(R * g.lda + C) * 2u; voffB[i] = (unsigned)(Rb * g.ldb + C) * 2u; }
    const size_t kstep = (size_t)(BK * 2);
    const size_t hstepA = (size_t)HALF * g.lda * 2, hstepB = (size_t)HALF * g.ldb * 2;
    const size_t tstepA = 2 * hstepA, tstepB = 2 * hstepB;
    const unsigned ldsw = (unsigned)wid * 1024u;
    const int aoff = lds_byte(wr * 64 + fr, fq * 8), boff = lds_byte(wc * 32 + fr, fq * 8);
#define PG8_SA(b, h) (((b) * 2 + (h)) * HTB)
#define PG8_SB(b, h) ((4 + (b) * 2 + (h)) * HTB)
#define PG8_STAGE(bufoff, gbase, voff) do { _Pragma("unroll") for (int _i = 0; _i < 2; ++_i) \
        __builtin_amdgcn_global_load_lds((const unsigned*)((const char*)(gbase) + (voff)[_i]), (PG8_LAS unsigned*)(lds + (bufoff) + ldsw + _i * 8192), 16, 0, 0); } while (0)
#define PG8_LDA(dst, b, h) do { _Pragma("unroll") for (int m = 0; m < 4; ++m) _Pragma("unroll") for (int k = 0; k < 2; ++k) dst[m][k] = *(const PG8_LAS bf16x8*)(lds + PG8_SA(b, h) + aoff + m * 2048 + k * 1024); } while (0)
#define PG8_LDB(dst, b, h) do { _Pragma("unroll") for (int n = 0; n < 2; ++n) _Pragma("unroll") for (int k = 0; k < 2; ++k) dst[n][k] = *(const PG8_LAS bf16x8*)(lds + PG8_SB(b, h) + boff + n * 2048 + k * 1024); } while (0)
#define PG8_MMA(ai, bj, At, Bt) do { __builtin_amdgcn_s_setprio(1); _Pragma("unroll") for (int m = 0; m < 4; ++m) _Pragma("unroll") for (int n = 0; n < 2; ++n) _Pragma("unroll") for (int k = 0; k < 2; ++k) \
        acc[ai][bj][m][n] = __builtin_amdgcn_mfma_f32_16x16x32_bf16(Bt[n][k], At[m][k], acc[ai][bj][m][n], 0, 0, 0); __builtin_amdgcn_s_setprio(0); } while (0)
#define PG8_WAIT_V(n) asm volatile("s_waitcnt vmcnt(" #n ")" ::: "memory")
#define PG8_WAIT_L(n) asm volatile("s_waitcnt lgkmcnt(" #n ")" ::: "memory")
#define PG8_BAR __builtin_amdgcn_s_barrier()
#define PG8_SCHED __builtin_amdgcn_sched_barrier(0)
#define PG8_APTR(u) ((const char*)g.A + ((size_t)(u).gb * g.bsA) * 2 + (size_t)(u).pm * tstepA)
#define PG8_BPTR(u) ((const char*)g.Bt + ((size_t)(u).gb * g.bsB) * 2 + (size_t)(u).pn * tstepB)
    Unit cur, nxt; int ui = 0;
    if (!S.next(0, cur)) return;
    f32x4 acc[2][2][4][2];
#pragma unroll
    for (int a = 0; a < 2; ++a)
#pragma unroll
        for (int b = 0; b < 2; ++b)
#pragma unroll
            for (int m = 0; m < 4; ++m)
#pragma unroll
                for (int n = 0; n < 2; ++n) acc[a][b][m][n] = (f32x4){0.f, 0.f, 0.f, 0.f};
    bf16x8 At[4][2], B0[2][2], B1[2][2];
    const char* cA = PG8_APTR(cur); const char* cB = PG8_BPTR(cur);
    PG8_STAGE(PG8_SB(0, 0), cB, voffB); PG8_STAGE(PG8_SB(0, 1), cB + hstepB, voffB); PG8_STAGE(PG8_SA(0, 0), cA, voffA); PG8_STAGE(PG8_SA(0, 1), cA + hstepA, voffA);
    if (wr == 1) PG8_BAR;
    PG8_WAIT_V(2); PG8_BAR;
    PG8_STAGE(PG8_SB(1, 0), cB + kstep, voffB); PG8_STAGE(PG8_SA(1, 0), cA + kstep, voffA); PG8_STAGE(PG8_SB(1, 1), cB + hstepB + kstep, voffB);
    PG8_WAIT_V(6); PG8_BAR;
    for (;;) {
        const bool has_next = S.next(ui + 1, nxt);
        const char* nA = has_next ? PG8_APTR(nxt) : cA; const char* nB = has_next ? PG8_BPTR(nxt) : cB;
        for (int t = 0; t < nt; t += 2) {
            const bool last = (t == nt - 2);
            const char* a1 = cA + (size_t)(t + 1) * kstep;
            const char* a2 = last ? nA : cA + (size_t)(t + 2) * kstep; const char* b2 = last ? nB : cB + (size_t)(t + 2) * kstep;
            const char* a3 = a2 + kstep; const char* b3 = b2 + kstep;
            PG8_LDB(B0, 0, 0); PG8_LDB(B1, 0, 1); PG8_SCHED; PG8_LDA(At, 0, 0); PG8_STAGE(PG8_SA(1, 1), a1 + hstepA, voffA);
            PG8_WAIT_V(8); PG8_WAIT_L(0); PG8_BAR; PG8_MMA(0, 0, At, B0); PG8_MMA(0, 1, At, B1); PG8_BAR; PG8_SCHED;
            PG8_LDA(At, 0, 1); PG8_STAGE(PG8_SB(0, 0), b2, voffB); PG8_STAGE(PG8_SB(0, 1), b2 + hstepB, voffB); PG8_STAGE(PG8_SA(0, 0), a2, voffA);
            PG8_WAIT_V(8); PG8_WAIT_L(0); PG8_BAR; PG8_MMA(1, 0, At, B0); PG8_MMA(1, 1, At, B1); PG8_BAR; PG8_SCHED;
            PG8_LDB(B0, 1, 0); PG8_LDB(B1, 1, 1); PG8_SCHED; PG8_LDA(At, 1, 0); PG8_STAGE(PG8_SA(0, 1), a2 + hstepA, voffA);
            PG8_WAIT_V(8); PG8_WAIT_L(0); PG8_BAR; PG8_MMA(0, 0, At, B0); PG8_MMA(0, 1, At, B1); PG8_BAR; PG8_SCHED;
            PG8_LDA(At, 1, 1); PG8_STAGE(PG8_SB(1, 0), b3, voffB); PG8_STAGE(PG8_SB(1, 1), b3 + hstepB, voffB); PG8_STAGE(PG8_SA(1, 0), a3, voffA);
            PG8_WAIT_V(8); PG8_WAIT_L(0); PG8_BAR; PG8_MMA(1, 0, At, B0); PG8_MMA(1, 1, At, B1); PG8_BAR; PG8_SCHED;
        }
        if constexpr (ALIGN_EPI) { if (wr == 0) PG8_BAR; }
        E(acc, cur, wr, wc, fr, fq);
        if (!has_next) break;
#pragma unroll
        for (int a = 0; a < 2; ++a)
#pragma unroll
            for (int b = 0; b < 2; ++b)
#pragma unroll
                for (int m = 0; m < 4; ++m)
#pragma unroll
                    for (int n = 0; n < 2; ++n) acc[a][b][m][n] = (f32x4){0.f, 0.f, 0.f, 0.f};
        cur = nxt; cA = nA; cB = nB; ++ui;
        if constexpr (ALIGN_EPI) { if (wr == 1) PG8_BAR; }
    }
    PG8_WAIT_V(0);
    if constexpr (!ALIGN_EPI) { if (wr == 0) PG8_BAR; }
    PG8_BAR;
#undef PG8_SA
#undef PG8_SB
#undef PG8_STAGE
#undef PG8_LDA
#undef PG8_LDB
#undef PG8_MMA
#undef PG8_WAIT_V
#undef PG8_WAIT_L
#undef PG8_BAR
#undef PG8_SCHED
#undef PG8_APTR
#undef PG8_BPTR
}
}
constexpr int NWAVES = 8;
constexpr int DM = 1024, BP = 8, SEQ = 2048, BS = 128, TS = 4;
constexpr int MP = BP * SEQ, MS = BS * TS, MT = MP + MS;
constexpr int INW = 2048, MIX = 768, NMEM = 256, NG = 48, NP = 64, NC = 16, NH = 12;
constexpr int PRW = 1280;
constexpr int KVW = 3584;
constexpr int UGK = 384;
constexpr float ALPHA = 1.41421356237309515f, LN_EPS = 1e-5f;
constexpr size_t O_Y = 0, O_MEMKV = 17301504, O_SRE_P = 19398656, O_SIM_P = 19423232, O_D1P = 19447808, O_D4P = 19972096,
                 O_D16P = 22069248, O_SRE_S = 30457856, O_SIM_S = 30851072, O_D1S = 31244288, O_D4S = 39632896, O_D16S = 73187328;
constexpr size_t MiB = 1u << 20;
constexpr size_t WS_CTL = 0, CTL_ZERO_BYTES = 1 * MiB;
constexpr size_t WS_WIN0 = 1 * MiB;
constexpr size_t WS_WB1 = 5 * MiB;
constexpr size_t WS_WOUT0 = 12 * MiB;
constexpr size_t WS_WOUT1 = 14 * MiB;
constexpr size_t WS_WGLU = 16 * MiB;
constexpr size_t WS_WMEM = 18 * MiB;
constexpr size_t WS_MEMB = 20 * MiB;
constexpr size_t WS_PT = 24 * MiB;
constexpr size_t WS_TQ = 30 * MiB;
constexpr size_t WS_TAB = 39 * MiB;
constexpr size_t WS_MKVB = 40 * MiB;
constexpr size_t WS_XB = 44 * MiB;
constexpr size_t WS_UGH = 78 * MiB;
constexpr size_t WS_US = 114 * MiB;
constexpr size_t WS_PROJR = 115 * MiB;
constexpr size_t WS_SST = 157 * MiB;
constexpr size_t WS_Y = 181 * MiB;
constexpr size_t WS_A1 = 206 * MiB;
constexpr size_t WS_R = 240 * MiB;
constexpr size_t WS_X1 = 307 * MiB;
constexpr size_t WS_X1B = 374 * MiB;
constexpr size_t WS_KVP = 408 * MiB;
constexpr size_t WS_ATT = 524 * MiB;
constexpr size_t WS_LSE = 549 * MiB;
constexpr size_t WS_END = 551 * MiB;
constexpr int TB_L16R = 0, TB_L16I = 3072, TB_LBR = 6144, TB_LBI = 9216, TB_BBR = 12288, TB_BBI = 12288 + 49152;
constexpr int CW_BAR = 4096;

constexpr int RING_OFF = 0, RING_BYTES = 131072;
constexpr int LDSCTL_OFF = RING_BYTES, MISC_OFF = LDSCTL_OFF + 320;
constexpr int LDS_BYTES = 147456;

#define GAS __attribute__((address_space(1)))
#define LAS __attribute__((address_space(3)))
typedef unsigned short bf16;
typedef unsigned v4u __attribute__((ext_vector_type(4)));
typedef unsigned v2u __attribute__((ext_vector_type(2)));
typedef float f32x4 __attribute__((ext_vector_type(4)));
typedef short bf16x8 __attribute__((ext_vector_type(8)));
typedef GAS unsigned gu32;
#define RLX_AGENT __ATOMIC_RELAXED, __HIP_MEMORY_SCOPE_AGENT
#define LDS_WAIT() asm volatile("s_waitcnt lgkmcnt(0)" ::: "memory")
#define VM_WAIT() asm volatile("s_waitcnt vmcnt(0)" ::: "memory")
__device__ __forceinline__ unsigned f2bf(float f) { unsigned u = __builtin_bit_cast(unsigned, f); return (u + 0x7fffu + ((u >> 16) & 1u)) >> 16; }
__device__ __forceinline__ unsigned pk2(float lo, float hi) { return f2bf(lo) | (f2bf(hi) << 16); }
__device__ __forceinline__ float bf2f(unsigned short h) { return __uint_as_float((unsigned)h << 16); }

__device__ __forceinline__ int lane_id() { int l = (int)__builtin_amdgcn_mbcnt_hi(~0u, __builtin_amdgcn_mbcnt_lo(~0u, 0u)); asm volatile("" : "+v"(l)); return l; }
#define XB_TMO      128
#define XB_XCNT(j)  (256  + 64 * (j))
#define XB_XSUB(j)  (1280 + 64 * (j))
#define XB_XGEN(j)  (2304 + 64 * (j))
#define XB_TOP      3328
#define XB_TOPGEN   3392
#define XCD_BAR_WORDS 3456
#define XB_SPIN_CAP (1u << 18)
__device__ __forceinline__ unsigned xb_ld(unsigned* p)              { return __hip_atomic_load(p, __ATOMIC_RELAXED, __HIP_MEMORY_SCOPE_AGENT); }
__device__ __forceinline__ unsigned xb_add(unsigned* p, unsigned v) { return __hip_atomic_fetch_add(p, v, __ATOMIC_RELAXED, __HIP_MEMORY_SCOPE_AGENT); }
__device__ __forceinline__ unsigned xb_xcc_id() { return (unsigned)__builtin_amdgcn_s_getreg((3 << 11) | 20) & 0xFu; }
#define XB_SPIN(cond, bar) do { unsigned _sp = 0; while (cond) { __builtin_amdgcn_s_sleep(1); \
    if ((++_sp & 255u) == 0u) { if (xb_ld(&(bar)[XB_TMO])) break; if (_sp > XB_SPIN_CAP) { atomicAdd(&(bar)[XB_TMO], 1u); break; } } } } while (0)
struct XcdBarrier { unsigned* bar; unsigned x; volatile LAS unsigned* st; };
__device__ __forceinline__ XcdBarrier xcd_barrier_post(unsigned* bar, volatile LAS unsigned* st, int wave) {
    XcdBarrier b; b.bar = bar; b.x = xb_xcc_id(); b.st = st;
    if (wave == 0 && lane_id() == 0) (void)xb_add(&bar[XB_XCNT(b.x)], 1u);
    return b;
}
__device__ __forceinline__ void xcd_barrier_complete(unsigned* bar, unsigned x, unsigned& nloc, unsigned& nx) {
    const unsigned G = gridDim.x * gridDim.y * gridDim.z;
    unsigned sum, cnt, mine, sp = 0u;
    for (;;) {
        sum = 0u; cnt = 0u; mine = 0u;
#pragma unroll
        for (unsigned j = 0; j < 16; ++j) { const unsigned c = xb_ld(&bar[XB_XCNT(j)]); sum += c; cnt += (c > 0u) ? 1u : 0u; mine = (j == x) ? c : mine; }
        if (sum == G) break;
        __builtin_amdgcn_s_sleep(1);
        if ((++sp & 255u) == 0u) { if (xb_ld(&bar[XB_TMO])) break; if (sp > XB_SPIN_CAP) { atomicAdd(&bar[XB_TMO], 1u); break; } }
    }
    nloc = mine > 0u ? mine : 1u; nx = cnt > 0u ? cnt : 1u;
}
__device__ __forceinline__ void xcd_barrier(const XcdBarrier& b, int wave) {
    asm volatile("s_waitcnt vmcnt(0)" ::: "memory");
    __syncthreads();
    if (wave == 0 && lane_id() == 0) {
        unsigned* bar = b.bar;
        __builtin_amdgcn_s_waitcnt(0);
        unsigned nloc = b.st[0], nx = b.st[1];
        if (nloc == 0u) { xcd_barrier_complete(bar, b.x, nloc, nx); b.st[0] = nloc; b.st[1] = nx; }
        const unsigned old = xb_add(&bar[XB_XSUB(b.x)], 1u);
        const unsigned gen = old / nloc;
        if (old + 1u == (gen + 1u) * nloc) {
            __builtin_amdgcn_fence(__ATOMIC_RELEASE, "agent");
            asm volatile("s_waitcnt vmcnt(0)" ::: "memory");
            const unsigned og = xb_add(&bar[XB_TOP], 1u);
            const unsigned tg = og / nx;
            if (og + 1u == (tg + 1u) * nx) xb_add(&bar[XB_TOPGEN], 1u);
            else XB_SPIN(xb_ld(&bar[XB_TOPGEN]) == tg, bar);
            __builtin_amdgcn_fence(__ATOMIC_ACQUIRE, "agent");
            xb_add(&bar[XB_XGEN(b.x)], 1u);
            asm volatile("s_waitcnt vmcnt(0)" ::: "memory");
        } else {
            XB_SPIN(xb_ld(&bar[XB_XGEN(b.x)]) == gen, bar);
            __builtin_amdgcn_fence(__ATOMIC_ACQUIRE, "agent");
            asm volatile("s_waitcnt vmcnt(0)" ::: "memory");
        }
    }
    __syncthreads();
}

struct Frame {
    LAS unsigned char* lds;
    volatile LAS unsigned* MISC;
    gu32* ctl;
    int wave;
    int vcu, G;
    unsigned char* ws;
    float* out;
};
__device__ __forceinline__ float wave_sum(float v) {
#pragma unroll
    for (int o = 1; o < 64; o <<= 1) v += __shfl_xor(v, o);
    return v;
}
__device__ __forceinline__ float wave_max(float v) {
#pragma unroll
    for (int o = 1; o < 64; o <<= 1) v = fmaxf(v, __shfl_xor(v, o));
    return v;
}
__device__ __forceinline__ int opaque_i(int x) { asm volatile("" : "+v"(x)); return x; }
#define TID_OF(F) ((F).wave * 64 + lane_id())
__device__ __forceinline__ void p0_transpose_item(const float* W, int K, int N, bf16* WT, int row_off, LAS float* scr, int item, int lane) {
    const int nblk = N / 32, kb = item / nblk, nb = item % nblk, k0 = 64 * kb, n0 = 32 * nb;
#pragma unroll 8
    for (int i = 0; i < 32; ++i) { const int kk = 2 * i + (lane >> 5); scr[kk * 33 + (lane & 31)] = W[(size_t)(k0 + kk) * N + n0 + (lane & 31)]; }
    LDS_WAIT(); asm volatile("" ::: "memory");
    const int c = lane & 7;
#pragma unroll
    for (int j = 0; j < 4; ++j) { const int n = (lane >> 3) + 8 * j; const LAS float* s = scr + (8 * c) * 33 + n;
        v4u o; o.x = pk2(s[0 * 33], s[1 * 33]); o.y = pk2(s[2 * 33], s[3 * 33]); o.z = pk2(s[4 * 33], s[5 * 33]); o.w = pk2(s[6 * 33], s[7 * 33]);
        *(GAS v4u*)(WT + (size_t)(row_off + n0 + n) * K + k0 + 8 * c) = o; }
    LDS_WAIT(); asm volatile("" ::: "memory");
}
__device__ __forceinline__ void row_to_bf16(const float* xrow, bf16* orow, int lane) {
    const GAS f32x4* xr = (const GAS f32x4*)xrow + lane;
    GAS unsigned long long* o8 = (GAS unsigned long long*)orow + lane;
#pragma unroll
    for (int j = 0; j < 4; ++j) { const f32x4 v = xr[64 * j]; o8[64 * j] = (unsigned long long)pk2(v.x, v.y) | ((unsigned long long)pk2(v.z, v.w) << 32); }
}
__device__ __forceinline__ void s5_tables_group(int g, const float* lam_re, const float* lam_im, const float* log_dt, const float* b_re, const float* b_im,
                                                const float* c_re, const float* c_im, const float* dsk, bf16* PT, bf16* TQ, float* TAB, LAS float* L, int tid) {
    LAS float* pwr = L;
    LAS float* pwi = L + 1088;
    LAS float* cre = L + 2176;
    LAS float* cim = L + 3200;
    LAS float* bbr = L + 4224;
    LAS float* bbi = L + 5248;
    LAS float* dk = L + 6272;
    LAS float* Kd = L + 6288;
    {
        const int p = tid & 63, dd = tid >> 6, gp = g * 64 + p;
        const double lr = fmin((double)lam_re[gp], -1e-4), li = (double)lam_im[gp], dt = exp((double)log_dt[g]);
        for (int d = dd; d <= 16; d += 8) {
            const double mag = exp((double)d * lr * dt), ang = (double)d * li * dt;
            pwr[d * 64 + p] = (float)(mag * cos(ang)); pwi[d * 64 + p] = (float)(mag * sin(ang));
            if (d == 16) { TAB[TB_L16R + gp] = (float)(mag * cos(ang)); TAB[TB_L16I + gp] = (float)(mag * sin(ang)); }
            if (d == 1) { TAB[TB_LBR + gp] = (float)(mag * cos(ang)); TAB[TB_LBI + gp] = (float)(mag * sin(ang)); }
        }
        if (dd == 0) {
            const double mag = exp(lr * dt), ang = li * dt, zr = mag * cos(ang), zi = mag * sin(ang);
            const double a = zr - 1.0, b = zi, den = lr * lr + li * li;
            const double cr = (a * lr + b * li) / den, ci = (b * lr - a * li) / den;
            for (int c = 0; c < 16; ++c) {
                const double br = b_re[gp * 16 + c], bi = b_im[gp * 16 + c];
                const float vr = (float)(cr * br - ci * bi), vi = (float)(cr * bi + ci * br);
                bbr[p * 16 + c] = vr; bbi[p * 16 + c] = vi;
                TAB[TB_BBR + gp * 16 + c] = vr; TAB[TB_BBI + gp * 16 + c] = vi;
            }
        }
        for (int i = tid; i < 1024; i += 512) { cre[i] = c_re[g * 1024 + i]; cim[i] = c_im[g * 1024 + i]; }
        if (tid < 16) dk[tid] = dsk[g * 16 + tid];
    }
    __syncthreads();
    for (int r = 0; r < 8; ++r) {
        const int idx = tid + 512 * r, d = idx >> 8, c = (idx >> 4) & 15, c2 = idx & 15;
        float s = 0.f;
        for (int p = 0; p < 64; ++p) {
            const float zr = cre[c * 64 + p] * pwr[d * 64 + p] - cim[c * 64 + p] * pwi[d * 64 + p];
            const float zi = cre[c * 64 + p] * pwi[d * 64 + p] + cim[c * 64 + p] * pwr[d * 64 + p];
            s += zr * bbr[p * 16 + c2] - zi * bbi[p * 16 + c2];
        }
        Kd[idx] = s;
    }
    __syncthreads();
    bf16* tq = TQ + (size_t)g * 256 * 384;
    for (int q = tid; q < 256 * 48; q += 512) {
        const int row = q / 48, kc = (q % 48) * 8, j = row >> 4, c = row & 15;
        float v[8];
        if (kc < 256) {
            const int i = kc >> 4, c0 = kc & 15;
#pragma unroll
            for (int e = 0; e < 8; ++e) { float x = 0.f; if (i <= j) { x = Kd[((j - i) << 8) + (c << 4) + c0 + e]; if (i == j && c == c0 + e) x += dk[c]; } v[e] = x; }
        } else {
            const int n0 = kc - 256;
#pragma unroll
            for (int e = 0; e < 8; ++e) { const int n = n0 + e, p = n & 63;
                const float zr = cre[c * 64 + p] * pwr[(j + 1) * 64 + p] - cim[c * 64 + p] * pwi[(j + 1) * 64 + p];
                const float zi = cre[c * 64 + p] * pwi[(j + 1) * 64 + p] + cim[c * 64 + p] * pwr[(j + 1) * 64 + p];
                v[e] = n < 64 ? zr : -zi; }
        }
        v4u o; o.x = pk2(v[0], v[1]); o.y = pk2(v[2], v[3]); o.z = pk2(v[4], v[5]); o.w = pk2(v[6], v[7]);
        *(GAS v4u*)(tq + (size_t)row * 384 + kc) = o;
    }
    bf16* pt = PT + (size_t)g * 256 * 256;
    for (int q = tid; q < 256 * 32; q += 512) {
        const int n = q >> 5, kc = (q & 31) * 8, i = kc >> 4, c0 = kc & 15, p = n & 63;
        float v[8];
#pragma unroll
        for (int e = 0; e < 8; ++e) {
            float x = 0.f;
            if (n < 128) { const float ar = pwr[(15 - i) * 64 + p], ai = pwi[(15 - i) * 64 + p], br = bbr[p * 16 + c0 + e], bi = bbi[p * 16 + c0 + e];
                x = n < 64 ? (ar * br - ai * bi) : (ar * bi + ai * br); }
            v[e] = x;
        }
        v4u o; o.x = pk2(v[0], v[1]); o.y = pk2(v[2], v[3]); o.z = pk2(v[4], v[5]); o.w = pk2(v[6], v[7]);
        *(GAS v4u*)(pt + (size_t)n * 256 + kc) = o;
    }
    __syncthreads();
}
template <int UNR>
__device__ __forceinline__ void copy_cache(const float* buf, float* out, int win, int wg, int nwg, int tid) {
    const long per_b = (long)(win - 4) * 128;
    const long ppb = per_b / 512;
    const long total = ppb * BS;
    for (long p0 = (long)wg * UNR; p0 < total; p0 += (long)nwg * UNR) {
        f32x4 v[UNR];
#pragma unroll
        for (int u = 0; u < UNR; ++u) { const long p = p0 + u; if (p < total) { const long b = p / ppb, r = (p % ppb) * 512 + tid;
            v[u] = __builtin_nontemporal_load((const f32x4*)buf + b * (long)win * 128 + 512 + r); } }
#pragma unroll
        for (int u = 0; u < UNR; ++u) { const long p = p0 + u; if (p < total) { const long b = p / ppb, r = (p % ppb) * 512 + tid;
            __builtin_nontemporal_store(v[u], (f32x4*)out + b * (long)win * 128 + r); } }
    }
}
__device__ __forceinline__ void p0_prologue(Frame& F, const float* const* in) {
    const int gw = F.vcu * NWAVES + F.wave, NGW = F.G * NWAVES;
    const int lane = lane_id();
    if (F.vcu < NG)
        s5_tables_group(F.vcu, in[14], in[15], in[16], in[17], in[18], in[19], in[20], in[21], (bf16*)(F.ws + WS_PT), (bf16*)(F.ws + WS_TQ), (float*)(F.ws + WS_TAB),
                        (LAS float*)(F.lds + RING_OFF), TID_OF(F));
    LAS float* scr = (LAS float*)(F.lds + RING_OFF + F.wave * 16384);
    constexpr int I0 = 16 * 64, I1 = 16 * 48, I2 = 16 * 64, I3 = 16 * 32, I4 = 16 * 32, I5 = 12 * 24, I6 = 16 * 16, I7 = 16 * 16;
    constexpr int NITEMS = I0 + I1 + I2 + I3 + I4 + I5 + I6 + I7;
    const float* w_in = in[9]; const float* w_out = in[10]; const float* w_mem = in[13]; const float* w_glu = in[22]; const float* w_kv = in[24];
    for (int it = gw; it < NITEMS; it += NGW) {
        int r = it;
        if (r < I0) { p0_transpose_item(w_in, 1024, 2048, (bf16*)(F.ws + WS_WIN0), 0, scr, r, lane); continue; } r -= I0;
        if (r < I1) { p0_transpose_item(w_kv, 1024, 1536, (bf16*)(F.ws + WS_WB1), 0, scr, r, lane); continue; } r -= I1;
        if (r < I2) { p0_transpose_item(w_in + (size_t)1024 * 2048, 1024, 2048, (bf16*)(F.ws + WS_WB1), 1536, scr, r, lane); continue; } r -= I2;
        if (r < I3) { p0_transpose_item(w_out, 1024, 1024, (bf16*)(F.ws + WS_WOUT0), 0, scr, r, lane); continue; } r -= I3;
        if (r < I4) { p0_transpose_item(w_out + (size_t)1024 * 1024, 1024, 1024, (bf16*)(F.ws + WS_WOUT1), 0, scr, r, lane); continue; } r -= I4;
        if (r < I5) { p0_transpose_item(w_glu, 768, 768, (bf16*)(F.ws + WS_WGLU), 0, scr, r, lane); continue; } r -= I5;
        if (r < I6) { p0_transpose_item(w_mem, 1024, 512, (bf16*)(F.ws + WS_WMEM), 0, scr, r, lane); continue; } r -= I6;
        p0_transpose_item(w_mem + (size_t)1024 * 512, 1024, 512, (bf16*)(F.ws + WS_WMEM), 512, scr, r, lane);
    }
    for (int m = gw; m < MT + BP * NMEM; m += NGW) {
        if (m < MP) row_to_bf16(in[0] + (size_t)m * DM, (bf16*)(F.ws + WS_XB) + (size_t)m * DM, lane);
        else if (m < MT) row_to_bf16(in[1] + (size_t)(m - MP) * DM, (bf16*)(F.ws + WS_XB) + (size_t)m * DM, lane);
        else row_to_bf16(in[8] + (size_t)(m - MT) * DM, (bf16*)(F.ws + WS_MEMB) + (size_t)(m - MT) * DM, lane);
    }
}

struct EpiProj0 {
    static constexpr bool PERM = true;
    bf16* UGH; bf16* US; bf16* PROJR;
    __device__ __forceinline__ void operator()(const pg8::f32x4 (&acc)[2][2][4][2], const pg8::Unit& u, int wr, int wc, int fr, int fq) const {
        const int row0 = u.pm * 256 + wr * 64 + fr, col0 = u.pn * 256 + wc * 32 + 8 * fq;
#pragma unroll
        for (int ai = 0; ai < 2; ++ai)
#pragma unroll
            for (int m = 0; m < 4; ++m) {
                const int row = row0 + ai * 128 + m * 16;
#pragma unroll
                for (int bj = 0; bj < 2; ++bj) {
                    const int col = col0 + bj * 128;
                    const pg8::f32x4 v0 = acc[ai][bj][m][0], v1 = acc[ai][bj][m][1];
                    pg8::u32x4 w; w.x = pg8::cvt_pk_bf16(v0[0], v0[1]); w.y = pg8::cvt_pk_bf16(v0[2], v0[3]); w.z = pg8::cvt_pk_bf16(v1[0], v1[1]); w.w = pg8::cvt_pk_bf16(v1[2], v1[3]);
                    bf16* dst;
                    if (u.pn < 3) {
                        if (u.pm < 64) { const int b = row >> 11, t = row & 2047, g = col >> 4;
                            dst = UGH + ((size_t)(g * 1024 + b * 128 + (t >> 4)) * UGK + (t & 15) * 16 + (col & 15)); }
                        else dst = US + (size_t)(row - MP) * MIX + col;
                    } else dst = PROJR + (size_t)row * PRW + (col - MIX);
                    *(pg8::u32x4*)dst = w;
                }
            }
    }
};
struct EpiMemKV {
    static constexpr bool PERM = false;
    float* out; bf16* MKVB;
    __device__ __forceinline__ void operator()(const pg8::f32x4 (&acc)[2][2][4][2], const pg8::Unit& u, int wr, int wc, int fr, int fq) const {
        const int row0 = u.pm * 256 + wr * 64 + fr, col0 = u.pn * 256 + wc * 32 + 4 * fq;
#pragma unroll
        for (int ai = 0; ai < 2; ++ai)
#pragma unroll
            for (int m = 0; m < 4; ++m) {
                const int row = row0 + ai * 128 + m * 16;
#pragma unroll
                for (int bj = 0; bj < 2; ++bj)
#pragma unroll
                    for (int n = 0; n < 2; ++n) {
                        const int col = col0 + bj * 128 + n * 16, l = col >> 9, k = col & 511;
                        const size_t idx = ((size_t)l * 2048 + row) * 512 + k;
                        const pg8::f32x4 v = acc[ai][bj][m][n];
                        *(pg8::f32x4*)(out + O_MEMKV + idx) = v;
                        pg8::u32x2 w; w.x = pg8::cvt_pk_bf16(v[0], v[1]); w.y = pg8::cvt_pk_bf16(v[2], v[3]);
                        *(pg8::u32x2*)(MKVB + idx) = w;
                    }
            }
    }
};
__device__ __forceinline__ float fast_sigmoid(float x) { return __builtin_amdgcn_rcpf(1.f + __builtin_amdgcn_exp2f(-1.4426950408889634f * x)); }
__device__ __forceinline__ float fast_silu(float x) { return x * fast_sigmoid(x); }
__device__ __forceinline__ float fast_gelu_tanh(float x) { const float z = 0.7978845608028654f * (x + 0.044715f * x * x * x); return x * fast_sigmoid(2.f * z); }
struct EpiS {
    static constexpr bool PERM = false;
    float* SST;
    __device__ __forceinline__ void operator()(const pg8::f32x4 (&acc)[2][2][4][2], const pg8::Unit& u, int wr, int wc, int fr, int fq) const {
        const int row0 = u.pm * 256 + wr * 64 + fr, col0 = wc * 32 + 4 * fq;
#pragma unroll
        for (int ai = 0; ai < 2; ++ai)
#pragma unroll
            for (int m = 0; m < 4; ++m) {
                const int row = row0 + ai * 128 + m * 16;
#pragma unroll
                for (int n = 0; n < 2; ++n) *(pg8::f32x4*)(SST + ((size_t)(u.gb * 1024 + row) * 128 + col0 + n * 16)) = acc[ai][0][m][n];
            }
    }
};
__device__ __forceinline__ void s5_carry_scan(const pg8::Unit& u, const float* __restrict__ SST, bf16* __restrict__ UGH, const float* __restrict__ TAB, float* __restrict__ out, int tid) {
    if (tid < 128) {
        const int bl = tid >> 6, p = tid & 63, g = u.gb, b = 2 * u.pm + bl;
        const float lr = TAB[TB_L16R + g * 64 + p], li = TAB[TB_L16I + g * 64 + p];
        float hr = 0.f, hi = 0.f;
        const float* s = SST + (size_t)(g * 1024 + b * 128) * 128 + p;
        bf16* h = UGH + (size_t)(g * 1024 + b * 128) * UGK + 256 + p;
        float cr[16], ci[16], nr_[16], ni_[16];
#pragma unroll
        for (int j = 0; j < 16; ++j) { cr[j] = s[(size_t)j * 128]; ci[j] = s[(size_t)j * 128 + 64]; }
#pragma unroll 1
        for (int k0 = 0; k0 < 128; k0 += 16) {
            if (k0 + 16 < 128) {
#pragma unroll
                for (int j = 0; j < 16; ++j) { nr_[j] = s[(size_t)(k0 + 16 + j) * 128]; ni_[j] = s[(size_t)(k0 + 16 + j) * 128 + 64]; }
            }
#pragma unroll
            for (int j = 0; j < 16; ++j) {
                h[(size_t)(k0 + j) * UGK] = (bf16)f2bf(hr); h[(size_t)(k0 + j) * UGK + 64] = (bf16)f2bf(hi);
                const float nr = lr * hr - li * hi + cr[j], ni = lr * hi + li * hr + ci[j];
                hr = nr; hi = ni;
            }
#pragma unroll
            for (int j = 0; j < 16; ++j) { cr[j] = nr_[j]; ci[j] = ni_[j]; }
        }
        out[O_SRE_P + (size_t)(b * 48 + g) * 64 + p] = hr; out[O_SIM_P + (size_t)(b * 48 + g) * 64 + p] = hi;
    }
}
struct EpiY {
    static constexpr bool PERM = true;
    bf16* Y;
    __device__ __forceinline__ void operator()(const pg8::f32x4 (&acc)[2][2][4][2], const pg8::Unit& u, int wr, int wc, int fr, int fq) const {
        const int row0 = u.pm * 256 + wr * 64 + fr, col0 = wc * 32 + 8 * fq;
#pragma unroll
        for (int ai = 0; ai < 2; ++ai)
#pragma unroll
            for (int m = 0; m < 4; ++m) {
                const int R = row0 + ai * 128 + m * 16, b = R >> 7, k = R & 127;
#pragma unroll
                for (int bj = 0; bj < 2; ++bj) {
                    const int col = col0 + bj * 128, j = col >> 4, c0 = col & 15;
                    const pg8::f32x4 v0 = acc[ai][bj][m][0], v1 = acc[ai][bj][m][1];
                    pg8::u32x4 w;
                    w.x = pg8::cvt_pk_bf16(fast_gelu_tanh(v0[0]), fast_gelu_tanh(v0[1])); w.y = pg8::cvt_pk_bf16(fast_gelu_tanh(v0[2]), fast_gelu_tanh(v0[3]));
                    w.z = pg8::cvt_pk_bf16(fast_gelu_tanh(v1[0]), fast_gelu_tanh(v1[1])); w.w = pg8::cvt_pk_bf16(fast_gelu_tanh(v1[2]), fast_gelu_tanh(v1[3]));
                    *(pg8::u32x4*)(Y + ((size_t)(b * 2048 + k * 16 + j) * MIX + u.gb * 16 + c0)) = w;
                }
            }
    }
};
__device__ __forceinline__ void s5_sample_task(int b, int g, const float* const* in, const float* TAB, const bf16* US, bf16* Y, float* out, int lane) {
    const int gp = g * 64 + lane;
    const float lr = TAB[TB_LBR + gp], li = TAB[TB_LBI + gp];
    float br[16], bi[16], cr[16], ci[16];
#pragma unroll
    for (int q = 0; q < 4; ++q) { const f32x4 a = *(const f32x4*)(TAB + TB_BBR + gp * 16 + 4 * q), c = *(const f32x4*)(TAB + TB_BBI + gp * 16 + 4 * q);
        br[4 * q] = a.x; br[4 * q + 1] = a.y; br[4 * q + 2] = a.z; br[4 * q + 3] = a.w; bi[4 * q] = c.x; bi[4 * q + 1] = c.y; bi[4 * q + 2] = c.z; bi[4 * q + 3] = c.w; }
#pragma unroll
    for (int c = 0; c < 16; ++c) { cr[c] = in[19][(size_t)(g * 16 + c) * 64 + lane]; ci[c] = in[20][(size_t)(g * 16 + c) * 64 + lane]; }
    float hr = in[3][(size_t)(b * 48 + g) * 64 + lane], hi = in[4][(size_t)(b * 48 + g) * 64 + lane];
    float v[64];
#pragma unroll
    for (int t = 0; t < 4; ++t) {
        const bf16* up = US + (size_t)(b * 4 + t) * MIX + g * 16;
        const v4u u0 = *(const v4u*)up, u1 = *(const v4u*)(up + 8);
        float uu[16];
        uu[0] = pg8::bf_lo(u0.x); uu[1] = pg8::bf_hi(u0.x); uu[2] = pg8::bf_lo(u0.y); uu[3] = pg8::bf_hi(u0.y); uu[4] = pg8::bf_lo(u0.z); uu[5] = pg8::bf_hi(u0.z); uu[6] = pg8::bf_lo(u0.w); uu[7] = pg8::bf_hi(u0.w);
        uu[8] = pg8::bf_lo(u1.x); uu[9] = pg8::bf_hi(u1.x); uu[10] = pg8::bf_lo(u1.y); uu[11] = pg8::bf_hi(u1.y); uu[12] = pg8::bf_lo(u1.z); uu[13] = pg8::bf_hi(u1.z); uu[14] = pg8::bf_lo(u1.w); uu[15] = pg8::bf_hi(u1.w);
        float bur = 0.f, bui = 0.f;
#pragma unroll
        for (int c = 0; c < 16; ++c) { bur += br[c] * uu[c]; bui += bi[c] * uu[c]; }
        const float nr = lr * hr - li * hi + bur, ni = lr * hi + li * hr + bui;
        hr = nr; hi = ni;
#pragma unroll
        for (int c = 0; c < 16; ++c) v[t * 16 + c] = cr[c] * hr - ci[c] * hi;
    }
    out[O_SRE_S + (size_t)(b * 48 + g) * 64 + lane] = hr; out[O_SIM_S + (size_t)(b * 48 + g) * 64 + lane] = hi;
#define TR_STEP(N, MSK, SH) { const bool bit = (lane >> SH) & 1; _Pragma("unroll") for (int i = 0; i < N / 2; ++i) { const float send = bit ? v[i] : v[i + N / 2]; const float keep = bit ? v[i + N / 2] : v[i]; v[i] = keep + __shfl_xor(send, MSK); } }
    TR_STEP(64, 32, 5) TR_STEP(32, 16, 4) TR_STEP(16, 8, 3) TR_STEP(8, 4, 2) TR_STEP(4, 2, 1) TR_STEP(2, 1, 0)
#undef TR_STEP
    const int t = lane >> 4, c = lane & 15;
    const float uv = bf2f(US[(size_t)(b * 4 + t) * MIX + g * 16 + c]);
    const float y = v[0] + in[21][g * 16 + c] * uv;
    Y[(size_t)(MP + b * 4 + t) * MIX + g * 16 + c] = (bf16)f2bf(fast_gelu_tanh(y));
}
struct EpiGlu {
    static constexpr bool PERM = true;
    const bf16* Y; const bf16* PROJR; const float* b_glu; bf16* A1;
    __device__ __forceinline__ void operator()(const pg8::f32x4 (&acc)[2][2][4][2], const pg8::Unit& u, int wr, int wc, int fr, int fq) const {
        const int row0 = u.pm * 256 + wr * 64 + fr, col0 = u.pn * 256 + wc * 32 + 8 * fq;
#pragma unroll
        for (int bj = 0; bj < 2; ++bj) {
            const int col = col0 + bj * 128;
            const pg8::f32x4 b0 = *(const pg8::f32x4*)(b_glu + col), b1 = *(const pg8::f32x4*)(b_glu + col + 4);
#pragma unroll
            for (int ai = 0; ai < 2; ++ai)
#pragma unroll
                for (int m = 0; m < 4; ++m) {
                    const int row = row0 + ai * 128 + m * 16;
                    const pg8::u32x4 yv = *(const pg8::u32x4*)(Y + (size_t)row * MIX + col);
                    const pg8::u32x4 gv = *(const pg8::u32x4*)(PROJR + (size_t)row * PRW + col);
                    const pg8::f32x4 z0 = acc[ai][bj][m][0] + b0, z1 = acc[ai][bj][m][1] + b1;
                    float o[8];
                    o[0] = pg8::bf_lo(yv.x) * fast_sigmoid(z0[0]) * fast_silu(pg8::bf_lo(gv.x)); o[1] = pg8::bf_hi(yv.x) * fast_sigmoid(z0[1]) * fast_silu(pg8::bf_hi(gv.x));
                    o[2] = pg8::bf_lo(yv.y) * fast_sigmoid(z0[2]) * fast_silu(pg8::bf_lo(gv.y)); o[3] = pg8::bf_hi(yv.y) * fast_sigmoid(z0[3]) * fast_silu(pg8::bf_hi(gv.y));
                    o[4] = pg8::bf_lo(yv.z) * fast_sigmoid(z1[0]) * fast_silu(pg8::bf_lo(gv.z)); o[5] = pg8::bf_hi(yv.z) * fast_sigmoid(z1[1]) * fast_silu(pg8::bf_hi(gv.z));
                    o[6] = pg8::bf_lo(yv.w) * fast_sigmoid(z1[2]) * fast_silu(pg8::bf_lo(gv.w)); o[7] = pg8::bf_hi(yv.w) * fast_sigmoid(z1[3]) * fast_silu(pg8::bf_hi(gv.w));
                    pg8::u32x4 w; w.x = pg8::cvt_pk_bf16(o[0], o[1]); w.y = pg8::cvt_pk_bf16(o[2], o[3]); w.z = pg8::cvt_pk_bf16(o[4], o[5]); w.w = pg8::cvt_pk_bf16(o[6], o[7]);
                    *(pg8::u32x4*)(A1 + (size_t)row * DM + col) = w;
                }
        }
    }
};

typedef float f32x16 __attribute__((ext_vector_type(16)));
typedef short v4i16_t __attribute__((ext_vector_type(4)));
__device__ __forceinline__ void pv_tile(f32x16 (&o)[2], const f32x16& p, const LAS unsigned char* vl, int lane) {
    const int hh = lane >> 5, gq = lane >> 4, q = (lane & 15) >> 2, pp = lane & 3;
    const LAS unsigned char* base = vl + (4 * hh + q) * 128 + (16 * (gq & 1) + 4 * pp) * 2;
#pragma unroll
    for (int s = 0; s < 2; ++s) {
        pg8::u32x4 pw; pw.x = pg8::cvt_pk_bf16(p[8 * s + 0], p[8 * s + 1]); pw.y = pg8::cvt_pk_bf16(p[8 * s + 2], p[8 * s + 3]);
        pw.z = pg8::cvt_pk_bf16(p[8 * s + 4], p[8 * s + 5]); pw.w = pg8::cvt_pk_bf16(p[8 * s + 6], p[8 * s + 7]);
        const bf16x8 pa = __builtin_bit_cast(bf16x8, pw);
#pragma unroll
        for (int db = 0; db < 2; ++db) {
            const v4i16_t lo = __builtin_amdgcn_ds_read_tr16_b64_v4i16((LAS v4i16_t*)(base + (16 * s) * 128 + db * 64));
            const v4i16_t hi = __builtin_amdgcn_ds_read_tr16_b64_v4i16((LAS v4i16_t*)(base + (16 * s + 8) * 128 + db * 64));
            const bf16x8 vf = (bf16x8){lo[0], lo[1], lo[2], lo[3], hi[0], hi[1], hi[2], hi[3]};
            o[db] = __builtin_amdgcn_mfma_f32_32x32x16_bf16(pa, vf, o[db], 0, 0, 0);
        }
    }
}
__device__ __forceinline__ float half_max(float v) { return fmaxf(v, __shfl_xor(v, 32)); }
__device__ __forceinline__ float half_sum(float v) { return v + __shfl_xor(v, 32); }
__device__ __forceinline__ void load_kfrag(bf16x8 (&kf)[4], const bf16* krow, int hh) {
#pragma unroll
    for (int ks = 0; ks < 4; ++ks) kf[ks] = *(const bf16x8*)(krow + 16 * ks + 8 * hh);
}
__device__ __forceinline__ f32x16 qk_mma(const bf16x8 (&kf)[4], const bf16x8 (&qf)[4]) {
    f32x16 acc = {};
#pragma unroll
    for (int ks = 0; ks < 4; ++ks) acc = __builtin_amdgcn_mfma_f32_32x32x16_bf16(kf[ks], qf[ks], acc, 0, 0, 0);
    return acc;
}
template <class VRow> __device__ __forceinline__ void load_v_tile(v4u (&tmp)[4], const VRow& vrow, int lane) {
#pragma unroll
    for (int i = 0; i < 4; ++i) { const int piece = lane + 64 * i, key = piece >> 3, ch = piece & 7; tmp[i] = *(const v4u*)(vrow(key) + ch * 8); }
}
__device__ __forceinline__ void write_v_tile(LAS unsigned char* vl, const v4u (&tmp)[4], int lane) {
#pragma unroll
    for (int i = 0; i < 4; ++i) *(LAS v4u*)(vl + (lane + 64 * i) * 16) = tmp[i];
}
__device__ __forceinline__ float red16(float d) { d += __shfl_xor(d, 1); d += __shfl_xor(d, 2); d += __shfl_xor(d, 4); d += __shfl_xor(d, 8); return d; }
__device__ __forceinline__ float max16(float d) { d = fmaxf(d, __shfl_xor(d, 1)); d = fmaxf(d, __shfl_xor(d, 2)); d = fmaxf(d, __shfl_xor(d, 4)); d = fmaxf(d, __shfl_xor(d, 8)); return d; }
__device__ __forceinline__ f32x4 bf4_to_f4(v2u w) { return (f32x4){pg8::bf_lo(w.x), pg8::bf_hi(w.x), pg8::bf_lo(w.y), pg8::bf_hi(w.y)}; }
constexpr int SCP = 264;

__device__ __forceinline__ void mem_attn_prompt_task(int b, int h, int qblk, const bf16* qbase, const bf16* gbase, int qpitch, const bf16* mkv  ,
                                                     bf16* A1, LAS unsigned char* vl, int lane_in) {
    const int lane = lane_id(); (void)lane_in;
    const int qi = lane & 31, hh = lane >> 5;
    const size_t qrow = (size_t)b * SEQ + qblk * 32 + qi;
    bf16x8 qf[4];
#pragma unroll
    for (int ks = 0; ks < 4; ++ks) qf[ks] = *(const bf16x8*)(qbase + qrow * qpitch + h * 64 + 16 * ks + 8 * hh);
    const bf16* kb = mkv + (size_t)qi * 512 + h * 64;
    float mx = -1e30f;
    {
        bf16x8 kf[4], kn[4];
        load_kfrag(kf, kb, hh);
#pragma unroll 1
        for (int kt = 0; kt < 8; ++kt) {
            if (kt + 1 < 8) load_kfrag(kn, kb + (size_t)(kt + 1) * 32 * 512, hh);
            const f32x16 st = qk_mma(kf, qf);
#pragma unroll
            for (int r = 0; r < 16; ++r) mx = fmaxf(mx, st[r]);
#pragma unroll
            for (int ks = 0; ks < 4; ++ks) kf[ks] = kn[ks];
        }
    }
    mx = half_max(mx);
    const float c2 = 0.125f * 1.4426950408889634f;
    float l = 0.f;
    f32x16 o[2] = {};
    {
        bf16x8 kf[4], kn[4]; v4u vt[4], vn[4];
        load_kfrag(kf, kb, hh);
        load_v_tile(vt, [&](int key) { return mkv + (size_t)key * 512 + 256 + h * 64; }, lane);
#pragma unroll 1
        for (int kt = 0; kt < 8; ++kt) {
            if (kt + 1 < 8) { load_kfrag(kn, kb + (size_t)(kt + 1) * 32 * 512, hh);
                              load_v_tile(vn, [&](int key) { return mkv + (size_t)((kt + 1) * 32 + key) * 512 + 256 + h * 64; }, lane); }
            f32x16 st = qk_mma(kf, qf);
#pragma unroll
            for (int r = 0; r < 16; ++r) { const float e = __builtin_amdgcn_exp2f((st[r] - mx) * c2); st[r] = e; l += e; }
            write_v_tile(vl, vt, lane);
            LDS_WAIT();
            pv_tile(o, st, vl, lane);
            LDS_WAIT();
#pragma unroll
            for (int ks = 0; ks < 4; ++ks) { kf[ks] = kn[ks]; vt[ks] = vn[ks]; }
        }
    }
    l = half_sum(l);
    const float il = 1.f / l;
#pragma unroll
    for (int r = 0; r < 16; ++r) {
        const int q = (r & 3) + 8 * (r >> 2) + 4 * hh;
        const float ilq = __shfl(il, q);
        const size_t row = (size_t)b * SEQ + qblk * 32 + q;
#pragma unroll
        for (int db = 0; db < 2; ++db) {
            const int d = db * 32 + qi;
            const float gate = bf2f(gbase[row * qpitch + h * 64 + d]);
            A1[row * DM + MIX + h * 64 + d] = (bf16)f2bf(o[db][r] * ilq * fast_silu(gate));
        }
    }
}
__device__ __forceinline__ void mem_attn_sample_wg(int srow, const bf16* qbase, const bf16* gbase, int qpitch, const float* cache_l  ,
                                                   bf16* A1, LAS float* scs, LAS f32x4* red, int wave) {
    const int lane = lane_id();
    const size_t row = (size_t)MP + srow;
    const float* kvu = cache_l + (size_t)(srow / TS) * NMEM * 512 + (size_t)wave * 512;
    const int l4 = lane * 4, li = lane & 15;
    LAS float* sch = scs + (lane >> 4) * SCP;
    const float c2 = 0.125f * 1.4426950408889634f;
    f32x4 q4 = bf4_to_f4(*(const v2u*)(qbase + row * qpitch + l4)); q4 = q4 * c2;
    {
        f32x4 kk[32];
#pragma unroll
        for (int i = 0; i < 32; ++i) kk[i] = *(const f32x4*)(kvu + (size_t)i * 8 * 512 + l4);
#pragma unroll
        for (int i = 0; i < 32; ++i) { const float d = red16(q4.x * kk[i].x + q4.y * kk[i].y + q4.z * kk[i].z + q4.w * kk[i].w); if (li == (i & 15)) sch[wave + 8 * i] = d; }
    }
    LDS_WAIT(); __syncthreads();
    float mx = -1e30f;
#pragma unroll
    for (int i = 0; i < NMEM / 16; ++i) mx = fmaxf(mx, sch[li + 16 * i]);
    mx = max16(mx);
    float sum = 0.f;
#pragma unroll
    for (int i = 0; i < NMEM / 16; ++i) sum += __builtin_amdgcn_exp2f(sch[li + 16 * i] - mx);
    sum = red16(sum);
    f32x4 o4 = {0.f, 0.f, 0.f, 0.f};
    {
        f32x4 vv[32];
#pragma unroll
        for (int i = 0; i < 32; ++i) vv[i] = *(const f32x4*)(kvu + (size_t)i * 8 * 512 + 256 + l4);
#pragma unroll
        for (int i = 0; i < 32; ++i) o4 = o4 + vv[i] * __builtin_amdgcn_exp2f(sch[wave + 8 * i] - mx);
    }
    red[wave * 64 + lane] = o4;
    LDS_WAIT(); __syncthreads();
    if (wave == 0) {
        f32x4 o = red[lane];
#pragma unroll
        for (int w = 1; w < 8; ++w) o = o + red[w * 64 + lane];
        const float inv = 1.f / sum;
        const f32x4 g4 = bf4_to_f4(*(const v2u*)(gbase + row * qpitch + l4));
        v2u w2; w2.x = pk2(o.x * inv * fast_silu(g4.x), o.y * inv * fast_silu(g4.y)); w2.y = pk2(o.z * inv * fast_silu(g4.z), o.w * inv * fast_silu(g4.w));
        *(v2u*)(A1 + row * DM + MIX + l4) = w2;
    }
    LDS_WAIT(); __syncthreads();
}
__device__ __forceinline__ void mem_attn_phase(Frame& F, int flags, int layer, const bf16* qbase, const bf16* gbase, int qpitch, const float* cache_mem, bf16* A1) {
    LDS_WAIT(); __syncthreads();
    if (!(flags & 2))
    for (int srow = F.vcu; srow < MS; srow += F.G)
        mem_attn_sample_wg(srow, qbase, gbase, qpitch, cache_mem + (size_t)layer * BS * NMEM * 512, A1, (LAS float*)(F.lds + RING_OFF), (LAS f32x4*)(F.lds + RING_OFF + 8192), F.wave);
    const int gw = F.vcu * NWAVES + F.wave, NGW = F.G * NWAVES;
    LAS unsigned char* wl = F.lds + RING_OFF + F.wave * 16384;
    const bf16* mkvb = (const bf16*)(F.ws + WS_MKVB) + (size_t)layer * BP * NMEM * 512;
    constexpr int NT_P = BP * 4 * (SEQ / 32);
    if (!(flags & 4))
    for (int tp = gw; tp < NT_P; tp += NGW) {
        const int qblk = tp % (SEQ / 32), bh = tp / (SEQ / 32), h = bh & 3, b = bh >> 2;
        mem_attn_prompt_task(b, h, qblk, qbase, gbase, qpitch, mkvb + (size_t)b * NMEM * 512, A1, wl, 0);
    }
}
struct EpiR {
    static constexpr bool PERM = false;
    const float* xa; const float* xb; float* R;
    __device__ __forceinline__ void operator()(const pg8::f32x4 (&acc)[2][2][4][2], const pg8::Unit& u, int wr, int wc, int fr, int fq) const {
        const int row0 = u.pm * 256 + wr * 64 + fr, col0 = u.pn * 256 + wc * 32 + 4 * fq;
        const float* xs = u.pm < 64 ? xa + (size_t)row0 * DM : xb + (size_t)(row0 - MP) * DM;
#pragma unroll
        for (int ai = 0; ai < 2; ++ai)
#pragma unroll
            for (int m = 0; m < 4; ++m) {
                const size_t ro = (size_t)(ai * 128 + m * 16) * DM;
#pragma unroll
                for (int bj = 0; bj < 2; ++bj)
#pragma unroll
                    for (int n = 0; n < 2; ++n) {
                        const int col = col0 + bj * 128 + n * 16;
                        const pg8::f32x4 xv = *(const pg8::f32x4*)(xs + ro + col);
                        *(pg8::f32x4*)(R + (size_t)row0 * DM + ro + col) = xv * ALPHA + acc[ai][bj][m][n];
                    }
            }
    }
};
__device__ __forceinline__ void ln_phase(Frame& F, const float* R, const float* gam, const float* bet, float* o32, bf16* ob) {
    const int gw = F.vcu * NWAVES + F.wave, NGW = F.G * NWAVES;
    const int lane_ = lane_id();
    f32x4 gv[4], bv[4];
#pragma unroll
    for (int j = 0; j < 4; ++j) { gv[j] = *((const f32x4*)gam + lane_ + 64 * j); bv[j] = *((const f32x4*)bet + lane_ + 64 * j); }
    for (int m = gw; m < MT; m += NGW) {
        const f32x4* xr = (const f32x4*)(R + (size_t)m * DM) + lane_;
        f32x4 v[4]; float s = 0.f;
#pragma unroll
        for (int j = 0; j < 4; ++j) { v[j] = xr[64 * j]; s += (v[j].x + v[j].y) + (v[j].z + v[j].w); }
        const float mean = wave_sum(s) * (1.f / DM); float s2 = 0.f;
#pragma unroll
        for (int j = 0; j < 4; ++j) { v[j] = v[j] - mean; s2 += (v[j].x * v[j].x + v[j].y * v[j].y) + (v[j].z * v[j].z + v[j].w * v[j].w); }
        const float rstd = 1.f / sqrtf(wave_sum(s2) * (1.f / DM) + LN_EPS);
#pragma unroll
        for (int j = 0; j < 4; ++j) {
            const f32x4 o = v[j] * rstd * gv[j] + bv[j];
            *((f32x4*)(o32 + (size_t)m * DM) + lane_ + 64 * j) = o;
            if (ob) { v2u w; w.x = pk2(o.x, o.y); w.y = pk2(o.z, o.w); *((v2u*)(ob + (size_t)m * DM) + lane_ + 64 * j) = w; }
        }
    }
}
struct EpiKVQ {
    static constexpr bool PERM = true;
    bf16* KVP; float* out;
    __device__ __forceinline__ void operator()(const pg8::f32x4 (&acc)[2][2][4][2], const pg8::Unit& u, int wr, int wc, int fr, int fq) const {
        const int row0 = u.pm * 256 + wr * 64 + fr, colt = wc * 32 + 8 * fq;
        const bool iskv = u.pn < 6;
        const int s = u.pn >= 3 ? 1 : 0, g = u.pn - 3 * s;
        const int win = g == 0 ? 128 : (g == 1 ? 512 : 2048);
        const size_t obase_p = g == 0 ? O_D1P : (g == 1 ? O_D4P : O_D16P), obase_s = g == 0 ? O_D1S : (g == 1 ? O_D4S : O_D16S);
#pragma unroll
        for (int ai = 0; ai < 2; ++ai)
#pragma unroll
            for (int m = 0; m < 4; ++m) {
                const int row = row0 + ai * 128 + m * 16;
#pragma unroll
                for (int bj = 0; bj < 2; ++bj) {
                    const int ct = colt + bj * 128;
                    const pg8::f32x4 v0 = acc[ai][bj][m][0], v1 = acc[ai][bj][m][1];
                    pg8::u32x4 w; w.x = pg8::cvt_pk_bf16(v0[0], v0[1]); w.y = pg8::cvt_pk_bf16(v0[2], v0[3]); w.z = pg8::cvt_pk_bf16(v1[0], v1[1]); w.w = pg8::cvt_pk_bf16(v1[2], v1[3]);
                    *(pg8::u32x4*)(KVP + (size_t)row * KVW + u.pn * 256 + ct) = w;
                    if (iskv) {
                        float* dst = nullptr;
                        if (u.pm < 64) { const int b = row >> 11, t = row & 2047;
                            if (t >= SEQ - win) dst = out + obase_p + ((size_t)(b * win + (t - (SEQ - win))) * 2 + s) * 256 + ct; }
                        else { const int rs = row - MP, b = rs >> 2, t = rs & 3;
                            dst = out + obase_s + ((size_t)(b * win + (win - 4 + t)) * 2 + s) * 256 + ct; }
                        if (dst) { *(pg8::f32x4*)dst = v0; *(pg8::f32x4*)(dst + 4) = v1; }
                    }
                }
            }
    }
};
__device__ __forceinline__ void dil_attn_prompt_task(int b, int h, int x, const bf16* KVP, bf16* ATT, float* LSE, LAS unsigned char* vl, int lane_in) {
    const int lane = lane_id(); (void)lane_in;
    const int qi = lane & 31, hh = lane >> 5, g = h >> 2;
    const int dil = g == 0 ? 1 : (g == 1 ? 4 : 16), nb = (SEQ / 32) / dil;
    const int r = x / nb, i0 = (x % nb) * 32;
    const float slope2 = __builtin_amdgcn_exp2f(-8.0f * (float)(h + 1) / 12.0f) * (float)dil * 1.4426950408889634f;
    const float c2 = 0.125f * 1.4426950408889634f;
    const bf16* base = KVP + (size_t)b * SEQ * KVW + h * 64;
    const size_t qrow = (size_t)(r + dil * (i0 + qi)) * KVW;
    bf16x8 qf[4];
#pragma unroll
    for (int ks = 0; ks < 4; ++ks) qf[ks] = *(const bf16x8*)(base + qrow + 1536 + 16 * ks + 8 * hh);
    const int kt0 = i0 >= 128 ? 0 : (128 - i0) / 32;
    const int ik0 = i0 - 128 + qi;
    float mx = -1e30f;
    {
        bf16x8 kf[4], kn[4];
        load_kfrag(kf, base + (size_t)(r + dil * (ik0 + 32 * kt0)) * KVW, hh);
#pragma unroll 1
        for (int kt = kt0; kt < 5; ++kt) {
            if (kt + 1 < 5) load_kfrag(kn, base + (size_t)(r + dil * (ik0 + 32 * (kt + 1))) * KVW, hh);
            const f32x16 st = qk_mma(kf, qf);
#pragma unroll
            for (int rr = 0; rr < 16; ++rr) {
                const int kk = (rr & 3) + 8 * (rr >> 2) + 4 * hh, m = qi + 128 - 32 * kt - kk;
                const float s2 = st[rr] * c2 - slope2 * (float)m;
                mx = (m >= 0 && m <= 128) ? fmaxf(mx, s2) : mx;
            }
#pragma unroll
            for (int ks = 0; ks < 4; ++ks) kf[ks] = kn[ks];
        }
    }
    mx = half_max(mx);
    float l = 0.f;
    f32x16 o[2] = {};
    {
        bf16x8 kf[4], kn[4]; v4u vt[4], vn[4];
        load_kfrag(kf, base + (size_t)(r + dil * (ik0 + 32 * kt0)) * KVW, hh);
        { const int ikb = i0 - 128 + 32 * kt0; load_v_tile(vt, [&](int key) { return base + (size_t)(r + dil * (ikb + key)) * KVW + 768; }, lane); }
#pragma unroll 1
        for (int kt = kt0; kt < 5; ++kt) {
            if (kt + 1 < 5) { load_kfrag(kn, base + (size_t)(r + dil * (ik0 + 32 * (kt + 1))) * KVW, hh);
                              const int ikb = i0 - 128 + 32 * (kt + 1); load_v_tile(vn, [&](int key) { return base + (size_t)(r + dil * (ikb + key)) * KVW + 768; }, lane); }
            f32x16 st = qk_mma(kf, qf);
#pragma unroll
            for (int rr = 0; rr < 16; ++rr) {
                const int kk = (rr & 3) + 8 * (rr >> 2) + 4 * hh, m = qi + 128 - 32 * kt - kk;
                const float e = (m >= 0 && m <= 128) ? __builtin_amdgcn_exp2f(st[rr] * c2 - slope2 * (float)m - mx) : 0.f;
                st[rr] = e; l += e;
            }
            write_v_tile(vl, vt, lane);
            LDS_WAIT();
            pv_tile(o, st, vl, lane);
            LDS_WAIT();
#pragma unroll
            for (int ks = 0; ks < 4; ++ks) { kf[ks] = kn[ks]; vt[ks] = vn[ks]; }
        }
    }
    l = half_sum(l);
    const float il = 1.f / l;
    if (hh == 0) LSE[((size_t)b * SEQ + r + dil * (i0 + qi)) * NH + h] = mx + __builtin_amdgcn_logf(l);
#pragma unroll
    for (int rr = 0; rr < 16; ++rr) {
        const int q = (rr & 3) + 8 * (rr >> 2) + 4 * hh;
        const float ilq = __shfl(il, q);
        const size_t row = (size_t)b * SEQ + r + dil * (i0 + q);
#pragma unroll
        for (int db = 0; db < 2; ++db) ATT[row * MIX + h * 64 + db * 32 + qi] = (bf16)f2bf(o[db][rr] * ilq);
    }
}
__device__ __forceinline__ void dil_attn_sample_wg(int srow, const bf16* KVP, const float* buf1, const float* buf4, const float* buf16, bf16* A1, LAS float* scs, LAS f32x4* red, LAS float* msc, int wave) {
    const int lane = lane_id();
    const int b = srow >> 2, t = srow & 3, li = lane & 15, j = lane >> 4, l4 = lane * 4;
    const size_t row = (size_t)MP + srow;
    LAS float* sch = scs + j * SCP;
    const float c2 = 0.125f * 1.4426950408889634f;
#pragma unroll 1
    for (int g = 0; g < 3; ++g) {
        const int dil = g == 0 ? 1 : (g == 1 ? 4 : 16), Lb = g == 0 ? 128 : (g == 1 ? 512 : 2048);
        const float* buf = (g == 0 ? buf1 : (g == 1 ? buf4 : buf16)) + (size_t)b * Lb * 512;
        const float slope2 = __builtin_amdgcn_exp2f(-8.0f * (float)(4 * g + j + 1) / 12.0f) * (float)dil * 1.4426950408889634f;
        f32x4 q4 = bf4_to_f4(*(const v2u*)(KVP + row * KVW + 1536 + g * 256 + l4)); q4 = q4 * c2;
        const int mnew = g == 0 ? t + 1 : 1;
        const bf16* knew = KVP + ((size_t)MP + b * 4) * KVW + g * 256 + l4;
        if (wave == 0)
            for (int m = 0; m < mnew; ++m) {
                const f32x4 kk = bf4_to_f4(*(const v2u*)(knew + (size_t)(t - m * dil) * KVW));
                const float d = red16(q4.x * kk.x + q4.y * kk.y + q4.z * kk.z + q4.w * kk.w);
                if (li == 0) sch[m] = d - slope2 * (float)m;
            }
        {
            f32x4 kk[16];
#pragma unroll
            for (int i = 0; i < 16; ++i) { int m = mnew + wave + 8 * i; m = m <= 128 ? m : 128; kk[i] = *(const f32x4*)(buf + (size_t)(Lb + t - m * dil) * 512 + l4); }
#pragma unroll
            for (int i = 0; i < 16; ++i) { const int m = mnew + wave + 8 * i; const float d = red16(q4.x * kk[i].x + q4.y * kk[i].y + q4.z * kk[i].z + q4.w * kk[i].w);
                if (li == i && m <= 128) sch[m] = d - slope2 * (float)m; }
        }
        LDS_WAIT(); __syncthreads();
        float mx = -1e30f;
        for (int m = li; m <= 128; m += 16) mx = fmaxf(mx, sch[m]);
        mx = max16(mx);
        float sum = 0.f;
        for (int m = li; m <= 128; m += 16) sum += __builtin_amdgcn_exp2f(sch[m] - mx);
        sum = red16(sum);
        f32x4 o4 = {0.f, 0.f, 0.f, 0.f};
        if (wave == 0)
            for (int m = 0; m < mnew; ++m) o4 = o4 + bf4_to_f4(*(const v2u*)(knew + (size_t)(t - m * dil) * KVW + 768)) * __builtin_amdgcn_exp2f(sch[m] - mx);
        {
            f32x4 vv[16];
#pragma unroll
            for (int i = 0; i < 16; ++i) { int m = mnew + wave + 8 * i; m = m <= 128 ? m : 128; vv[i] = *(const f32x4*)(buf + (size_t)(Lb + t - m * dil) * 512 + 256 + l4); }
#pragma unroll
            for (int i = 0; i < 16; ++i) { const int m = mnew + wave + 8 * i; const float pw = m <= 128 ? __builtin_amdgcn_exp2f(sch[m <= 128 ? m : 128] - mx) : 0.f; o4 = o4 + vv[i] * pw; }
        }
        red[wave * 64 + lane] = o4;
        LDS_WAIT(); __syncthreads();
        if (wave == 0) {
            f32x4 o = red[lane];
#pragma unroll
            for (int w = 1; w < 8; ++w) o = o + red[w * 64 + lane];
            o = o * (1.f / sum);
            msc[(g * 5 + 0) * 64 + lane] = o.x; msc[(g * 5 + 1) * 64 + lane] = o.y; msc[(g * 5 + 2) * 64 + lane] = o.z; msc[(g * 5 + 3) * 64 + lane] = o.w;
            msc[(g * 5 + 4) * 64 + lane] = mx + __builtin_amdgcn_logf(sum);
        }
        LDS_WAIT(); __syncthreads();
    }
    if (wave == 0) {
        f32x4 og[3]; float lse[3];
#pragma unroll
        for (int g = 0; g < 3; ++g) { og[g] = (f32x4){msc[(g * 5 + 0) * 64 + lane], msc[(g * 5 + 1) * 64 + lane], msc[(g * 5 + 2) * 64 + lane], msc[(g * 5 + 3) * 64 + lane]}; lse[g] = msc[(g * 5 + 4) * 64 + lane]; }
        const float M = fmaxf(lse[0], fmaxf(lse[1], lse[2]));
        const float e0 = __builtin_amdgcn_exp2f(lse[0] - M), e1 = __builtin_amdgcn_exp2f(lse[1] - M), e2 = __builtin_amdgcn_exp2f(lse[2] - M);
        const float iden = 1.f / (e0 + e1 + e2);
        const float wg[3] = {e0 * iden, e1 * iden, e2 * iden};
#pragma unroll
        for (int g = 0; g < 3; ++g) {
            const f32x4 g4 = bf4_to_f4(*(const v2u*)(KVP + row * KVW + 2304 + g * 256 + l4));
            const f32x4 v = og[g] * wg[g];
            v2u w; w.x = pk2(v.x * fast_silu(g4.x), v.y * fast_silu(g4.y)); w.y = pk2(v.z * fast_silu(g4.z), v.w * fast_silu(g4.w));
            *(v2u*)(A1 + row * DM + g * 256 + l4) = w;
        }
    }
    LDS_WAIT(); __syncthreads();
}
__device__ __forceinline__ void dil_attn_phase(Frame& F, int flags, const float* const* in) {
    const bf16* KVP = (const bf16*)(F.ws + WS_KVP); bf16* ATT = (bf16*)(F.ws + WS_ATT); float* LSE = (float*)(F.ws + WS_LSE);
    LDS_WAIT(); __syncthreads();
    if (!(flags & 8))
    for (int srow = F.vcu; srow < MS; srow += F.G)
        dil_attn_sample_wg(srow, KVP, in[5], in[6], in[7], (bf16*)(F.ws + WS_A1), (LAS float*)(F.lds + RING_OFF), (LAS f32x4*)(F.lds + RING_OFF + 8192), (LAS float*)(F.lds + RING_OFF + 16384), F.wave);
    const int gw = F.vcu * NWAVES + F.wave, NGW = F.G * NWAVES;
    LAS unsigned char* wl = F.lds + RING_OFF + F.wave * 16384;
    constexpr int NT_P = BP * NH * (SEQ / 32);
    if (!(flags & 16))
    for (int tp = gw; tp < NT_P; tp += NGW) { const int x = tp % (SEQ / 32), bh = tp / (SEQ / 32), h = bh % NH, b = bh / NH; dil_attn_prompt_task(b, h, x, KVP, ATT, LSE, wl, 0); }
}
__device__ __forceinline__ void merge_gate_phase(Frame& F) {
    const bf16* KVP = (const bf16*)(F.ws + WS_KVP); const bf16* ATT = (const bf16*)(F.ws + WS_ATT); const float* LSE = (const float*)(F.ws + WS_LSE); bf16* A1 = (bf16*)(F.ws + WS_A1);
    const size_t gt = (size_t)F.vcu * NWAVES * 64 + TID_OF(F), nth = (size_t)F.G * NWAVES * 64;
    for (size_t i = gt; i < (size_t)MP * (MIX / 8); i += nth) {
        const size_t row = i / (MIX / 8); const int c = (int)(i % (MIX / 8)) * 8, h = c >> 6, j = h & 3;
        const float l0 = LSE[row * NH + j], l1 = LSE[row * NH + 4 + j], l2 = LSE[row * NH + 8 + j];
        const float mx = fmaxf(l0, fmaxf(l1, l2));
        const float den = __builtin_amdgcn_exp2f(l0 - mx) + __builtin_amdgcn_exp2f(l1 - mx) + __builtin_amdgcn_exp2f(l2 - mx);
        const float w = __builtin_amdgcn_exp2f(LSE[row * NH + h] - mx) / den;
        const v4u av = *(const v4u*)(ATT + row * MIX + c), gv = *(const v4u*)(KVP + row * KVW + 2304 + c);
        v4u o;
        o.x = pk2(pg8::bf_lo(av.x) * w * fast_silu(pg8::bf_lo(gv.x)), pg8::bf_hi(av.x) * w * fast_silu(pg8::bf_hi(gv.x)));
        o.y = pk2(pg8::bf_lo(av.y) * w * fast_silu(pg8::bf_lo(gv.y)), pg8::bf_hi(av.y) * w * fast_silu(pg8::bf_hi(gv.y)));
        o.z = pk2(pg8::bf_lo(av.z) * w * fast_silu(pg8::bf_lo(gv.z)), pg8::bf_hi(av.z) * w * fast_silu(pg8::bf_hi(gv.z)));
        o.w = pk2(pg8::bf_lo(av.w) * w * fast_silu(pg8::bf_lo(gv.w)), pg8::bf_hi(av.w) * w * fast_silu(pg8::bf_hi(gv.w)));
        *(v4u*)(A1 + row * DM + c) = o;
    }
}
#ifndef REP_LO
#define REP_LO 4
#define REP_HI 5
#endif
#ifndef REP_FLAGS
#define REP_FLAGS 6
#endif
struct Args { const float* in[25]; float* out; unsigned char* ws; int ph_lo, ph_hi, flags, pad; };
__global__ void __launch_bounds__(NWAVES * 64, 2) fwd(Args args) {
    extern __shared__ __attribute__((aligned(16))) unsigned char lds[];
    Frame F;
    F.lds = (LAS unsigned char*)lds;
    F.MISC = (volatile LAS unsigned*)(F.lds + MISC_OFF);
    F.wave = __builtin_amdgcn_readfirstlane((int)threadIdx.x >> 6);
    F.G = gridDim.x; { const int bx = blockIdx.x; F.vcu = (F.G % 8 == 0) ? (bx % 8) * (F.G / 8) + bx / 8 : bx; }
    F.ws = args.ws; F.out = args.out;
    F.ctl = (gu32*)(F.ws + WS_CTL);
    for (int u = TID_OF(F); u < (LDS_BYTES - LDSCTL_OFF) / 4; u += NWAVES * 64) ((LAS unsigned*)(F.lds + LDSCTL_OFF))[u] = 0u;
    __syncthreads();
    XcdBarrier bar = xcd_barrier_post((unsigned*)(F.ctl + CW_BAR), F.MISC + 8, F.wave);
    const int lo = args.ph_lo, hi = args.ph_hi;
#define IN(k) (lo <= (k) && (k) < hi)
#define BOTH(k) (IN(k) && IN((k) + 1))
    if (IN(0)) { p0_prologue(F, args.in);
        { const int tid_ = TID_OF(F);
          copy_cache<8>(args.in[5], F.out + O_D1S, 128, F.vcu, F.G, tid_); copy_cache<8>(args.in[6], F.out + O_D4S, 512, F.vcu, F.G, tid_); copy_cache<8>(args.in[7], F.out + O_D16S, 2048, F.vcu, F.G, tid_); }
 if (BOTH(0)) xcd_barrier(bar, F.wave); }
    if (IN(1)) {
        {
            pg8::Gemm g{(const bf16*)(F.ws + WS_XB), (const bf16*)(F.ws + WS_WIN0), 1024, 1024, 1024, 0, 0};
            pg8::StaticOrder S; S.init(MT, INW, F.G, (int)blockIdx.x);
            EpiProj0 E{(bf16*)(F.ws + WS_UGH), (bf16*)(F.ws + WS_US), (bf16*)(F.ws + WS_PROJR)};
            pg8::gemm_phase<EpiProj0, pg8::StaticOrder, true>(F.lds + RING_OFF, g, S, E, F.wave);
        }
        {
            pg8::Gemm g{(const bf16*)(F.ws + WS_MEMB), (const bf16*)(F.ws + WS_WMEM), 1024, 1024, 1024, 0, 0};
            pg8::StaticOrder S; S.init(BP * NMEM, 1024, F.G, (int)((blockIdx.x + 192u) % (unsigned)F.G));
            EpiMemKV E{F.out, (bf16*)(F.ws + WS_MKVB)};
            pg8::gemm_phase<EpiMemKV, pg8::StaticOrder, true>(F.lds + RING_OFF, g, S, E, F.wave);
        }
        if (BOTH(1)) xcd_barrier(bar, F.wave);
    }
    if (IN(2)) {
        pg8::Gemm g{(const bf16*)(F.ws + WS_UGH), (const bf16*)(F.ws + WS_PT), UGK, 256, 256, (size_t)1024 * UGK, (size_t)256 * 256};
        pg8::BatchOrder S; S.init(NG, 4, F.G, (int)blockIdx.x);
        EpiS E{(float*)(F.ws + WS_SST)};
        pg8::gemm_phase<EpiS, pg8::BatchOrder, true>(F.lds + RING_OFF, g, S, E, F.wave);
        if (BOTH(2)) xcd_barrier(bar, F.wave);
    }
    if (IN(3)) {
        pg8::Gemm g{(const bf16*)(F.ws + WS_UGH), (const bf16*)(F.ws + WS_TQ), UGK, UGK, UGK, (size_t)1024 * UGK, (size_t)256 * UGK};
        pg8::BatchOrder S; S.init(NG, 4, F.G, (int)blockIdx.x);
        { pg8::Unit u; for (int i = 0; S.next(i, u); ++i) s5_carry_scan(u, (const float*)(F.ws + WS_SST), (bf16*)(F.ws + WS_UGH), (const float*)(F.ws + WS_TAB), F.out, TID_OF(F)); }
        VM_WAIT(); __syncthreads();
        EpiY E{(bf16*)(F.ws + WS_Y)};
        pg8::gemm_phase<EpiY, pg8::BatchOrder, true>(F.lds + RING_OFF, g, S, E, F.wave);
        {
            const int lane = lane_id();
            const float* TAB = (const float*)(F.ws + WS_TAB);
            if ((int)blockIdx.x >= NG * 4) {
                const int nw = (F.G - NG * 4) * NWAVES;
                for (int task = ((int)blockIdx.x - NG * 4) * NWAVES + F.wave; task < 4096; task += nw)
                    s5_sample_task(task / NG, task % NG, args.in, TAB, (const bf16*)(F.ws + WS_US), (bf16*)(F.ws + WS_Y), F.out, lane);
            } else {
                for (int task = 4096 + (int)blockIdx.x * NWAVES + F.wave; task < BS * NG; task += NG * 4 * NWAVES)
                    s5_sample_task(task / NG, task % NG, args.in, TAB, (const bf16*)(F.ws + WS_US), (bf16*)(F.ws + WS_Y), F.out, lane);
            }
        }
        if (BOTH(3)) xcd_barrier(bar, F.wave);
    }
    if (IN(4)) {
        pg8::Gemm g{(const bf16*)(F.ws + WS_Y), (const bf16*)(F.ws + WS_WGLU), MIX, MIX, MIX, 0, 0};
        pg8::StaticOrder S; S.init(MT, MIX, F.G, (int)blockIdx.x);
        EpiGlu E{(const bf16*)(F.ws + WS_Y), (const bf16*)(F.ws + WS_PROJR), args.in[23], (bf16*)(F.ws + WS_A1)};
        if (!(args.flags & 1)) pg8::gemm_phase<EpiGlu, pg8::StaticOrder, true>(F.lds + RING_OFF, g, S, E, F.wave);
        mem_attn_phase(F, args.flags, 0, (const bf16*)(F.ws + WS_PROJR) + MIX, (const bf16*)(F.ws + WS_PROJR) + MIX + 256, PRW, args.in[2], (bf16*)(F.ws + WS_A1));
        if (BOTH(4)) xcd_barrier(bar, F.wave);
    }
    if (IN(5)) {
        pg8::Gemm g{(const bf16*)(F.ws + WS_A1), (const bf16*)(F.ws + WS_WOUT0), DM, DM, DM, 0, 0};
        pg8::StaticOrder S; S.init(MT, DM, F.G, (int)blockIdx.x);
        EpiR E{args.in[0], args.in[1], (float*)(F.ws + WS_R)};
        pg8::gemm_phase<EpiR, pg8::StaticOrder, true>(F.lds + RING_OFF, g, S, E, F.wave);
        if (BOTH(5)) xcd_barrier(bar, F.wave);
    }
    if (IN(6)) {
        ln_phase(F, (const float*)(F.ws + WS_R), args.in[11], args.in[12], (float*)(F.ws + WS_X1), (bf16*)(F.ws + WS_X1B));
        if (BOTH(6)) xcd_barrier(bar, F.wave);
    }
    if (IN(7)) {
        pg8::Gemm g{(const bf16*)(F.ws + WS_X1B), (const bf16*)(F.ws + WS_WB1), DM, DM, DM, 0, 0};
        pg8::StaticOrder S; S.init(MT, KVW, F.G, (int)blockIdx.x);
        EpiKVQ E{(bf16*)(F.ws + WS_KVP), F.out};
        pg8::gemm_phase<EpiKVQ, pg8::StaticOrder, true>(F.lds + RING_OFF, g, S, E, F.wave);
        if (BOTH(7)) xcd_barrier(bar, F.wave);
    }
    if (IN(8)) {
        dil_attn_phase(F, args.flags, args.in);
        mem_attn_phase(F, args.flags, 1, (const bf16*)(F.ws + WS_KVP) + 3072, (const bf16*)(F.ws + WS_KVP) + 3328, KVW, args.in[2], (bf16*)(F.ws + WS_A1));
        if (BOTH(8)) xcd_barrier(bar, F.wave);
    }
    if (IN(9)) { merge_gate_phase(F); if (BOTH(9)) xcd_barrier(bar, F.wave); }
    if (IN(10)) {
        pg8::Gemm g{(const bf16*)(F.ws + WS_A1), (const bf16*)(F.ws + WS_WOUT1), DM, DM, DM, 0, 0};
        pg8::StaticOrder S; S.init(MT, DM, F.G, (int)blockIdx.x);
        EpiR E{(const float*)(F.ws + WS_X1), (const float*)(F.ws + WS_X1) + (size_t)MP * DM, (float*)(F.ws + WS_R)};
        pg8::gemm_phase<EpiR, pg8::StaticOrder, true>(F.lds + RING_OFF, g, S, E, F.wave);
        if (BOTH(10)) xcd_barrier(bar, F.wave);
    }
    if (IN(11)) { ln_phase(F, (const float*)(F.ws + WS_R), args.in[11] + DM, args.in[12] + DM, F.out + O_Y, nullptr); }
#undef IN
#undef BOTH
}

__global__ void cvt_proj0(const bf16* UGH, const bf16* US, const bf16* PROJR, float* PROJ) {
    const size_t i = (size_t)blockIdx.x * blockDim.x + threadIdx.x;
    if (i >= (size_t)MT * INW) return;
    const int row = (int)(i / INW), col = (int)(i % INW);
    bf16 v;
    if (col < MIX) {
        if (row < MP) { const int b = row >> 11, t = row & 2047, g = col >> 4; v = UGH[(size_t)(g * 1024 + b * 128 + (t >> 4)) * UGK + (t & 15) * 16 + (col & 15)]; }
        else v = US[(size_t)(row - MP) * MIX + col];
    } else v = PROJR[(size_t)row * PRW + (col - MIX)];
    PROJ[i] = bf2f(v);
}

__global__ void cvt_bf16_f32(const bf16* src, float* dst, size_t n) {
    const size_t i = (size_t)blockIdx.x * blockDim.x + threadIdx.x;
    if (i < n) dst[i] = bf2f(src[i]);
}
__global__ void cvt_kvp(const bf16* KVP, float* KV, float* PROJ) {
    const size_t i = (size_t)blockIdx.x * blockDim.x + threadIdx.x;
    if (i >= (size_t)MT * KVW) return;
    const size_t row = i / KVW; const int col = (int)(i % KVW);
    const float v = bf2f(KVP[i]);
    if (col < 1536) KV[row * 1536 + col] = v; else PROJ[row * 2048 + (col - 1536)] = v;
}
extern "C" void kernel_launch(void* const* d_in, const int* in_sizes, int n_in, void* d_out, int out_size, void* d_ws, size_t ws_size, hipStream_t stream) {
    static int grid = 0;
    if (grid == 0) {
        int dev = 0, cus = 0, per_cu = 0;
        if (hipGetDevice(&dev) != hipSuccess || hipDeviceGetAttribute(&cus, hipDeviceAttributeMultiprocessorCount, dev) != hipSuccess) { fprintf(stderr, "kernel_launch: device query failed\n"); grid = -1; return; }
        if (hipFuncSetAttribute((const void*)fwd, hipFuncAttributeMaxDynamicSharedMemorySize, LDS_BYTES) != hipSuccess) { fprintf(stderr, "kernel_launch: hipFuncSetAttribute failed\n"); grid = -1; return; }
        if (hipOccupancyMaxActiveBlocksPerMultiprocessor(&per_cu, (const void*)fwd, NWAVES * 64, LDS_BYTES) != hipSuccess || per_cu < 1) { fprintf(stderr, "kernel_launch: occupancy query says %d\n", per_cu); per_cu = 1; }
        (void)hipGetLastError();
        grid = cus * 1;
        if (per_cu != 1) fprintf(stderr, "kernel_launch: note: occupancy query reports %d blocks/CU\n", per_cu);
    }
    if (grid < 0) return;
    hipMemsetAsync((char*)d_ws + WS_CTL, 0, CTL_ZERO_BYTES, stream);
    Args a{};
    for (int i = 0; i < 25; ++i) a.in[i] = (const float*)d_in[i];
    a.out = (float*)d_out; a.ws = (unsigned char*)d_ws; a.ph_lo = 0; a.ph_hi = 12;
    void* kargs[] = {&a};
    hipError_t e = hipLaunchCooperativeKernel((const void*)fwd, dim3(grid), dim3(NWAVES * 64), kargs, LDS_BYTES, stream);
    if (e != hipSuccess) fprintf(stderr, "kernel_launch: cooperative launch failed: %s\n", hipGetErrorString(e));
#if REP_HI > REP_LO
    hipMemsetAsync((char*)d_ws + WS_CTL, 0, CTL_ZERO_BYTES, stream);
    Args a2 = a; a2.ph_lo = REP_LO; a2.ph_hi = REP_HI; a2.flags = REP_FLAGS; void* kargs2[] = {&a2};
    hipLaunchCooperativeKernel((const void*)fwd, dim3(grid), dim3(NWAVES * 64), kargs2, LDS_BYTES, stream);
#endif

}
```

```cpp
#include <hip/hip_runtime.h>
#include <cstdio>
#include <cstdint>
#include <math.h>
namespace pg8 {
#define PG8_LAS __attribute__((address_space(3)))
typedef unsigned short bf16_t;
typedef short bf16x8 __attribute__((ext_vector_type(8)));
typedef float f32x4 __attribute__((ext_vector_type(4)));
typedef float f32x2 __attribute__((ext_vector_type(2)));
typedef unsigned u32x4 __attribute__((ext_vector_type(4)));
typedef unsigned u32x2 __attribute__((ext_vector_type(2)));
constexpr int BM = 256, BK = 64, HALF = 128, HTB = HALF * BK * 2, STAGE_BYTES = 8 * HTB, NXCD = 8, WGM = 8;

__host__ __device__ __forceinline__ int lds_byte(int r, int c) { const int st = (r >> 4) * 2 + (c >> 5), rr = r & 15, cc = c & 31, ob = rr * 64 + cc * 2; return st * 1024 + (ob ^ (((ob >> 9) & 1) << 5)); }
__host__ __device__ __forceinline__ void stage_rc(int b, int& R, int& C) { const int st = b / 1024, sb = b % 1024, swz = sb ^ (((sb >> 9) & 1) << 5); R = (st >> 1) * 16 + swz / 64; C = (st & 1) * 32 + (swz % 64) / 2; }
__host__ __device__ __forceinline__ int perm32(int rho) { const int n = rho >> 4, i = rho & 15; return 8 * (i >> 2) + 4 * n + (i & 3); }

struct Unit { int pm, pn, gb; };
struct Gemm { const bf16_t* A; const bf16_t* Bt; int lda, ldb, K; size_t bsA, bsB; };

struct StaticOrder {
    int nM, nN, nwg, G, c;
    __device__ __forceinline__ void init(int M, int N, int G_, int c_) { nM = M / BM; nN = N / BM; nwg = nM * nN; G = G_; c = c_; }
    __device__ __forceinline__ bool next(int i, Unit& u) const {
        const long L = (long)i * G + c; if (L >= nwg) return false;
        int wgid = (int)L; { const int q = nwg / NXCD, r = nwg % NXCD, xcd = wgid % NXCD, off = wgid / NXCD; wgid = (xcd < r ? xcd * (q + 1) : r * (q + 1) + (xcd - r) * q) + off; }
        const int nig = WGM * nN, gid = wgid / nig, fm = gid * WGM, gsz = (nM - fm) < WGM ? (nM - fm) : WGM;
        u.pm = fm + ((wgid % nig) % gsz); u.pn = (wgid % nig) / gsz; u.gb = 0; return true;
    }
};
struct BatchOrder {
    int nM, nwg, G, c;
    __device__ __forceinline__ void init(int nB, int nM_, int G_, int c_) { nM = nM_; nwg = nB * nM_; G = G_; c = c_; }
    __device__ __forceinline__ bool next(int i, Unit& u) const { const long L = (long)i * G + c; if (L >= nwg) return false; u.gb = (int)L / nM; u.pm = (int)L % nM; u.pn = 0; return true; }
};

__device__ __forceinline__ unsigned cvt_pk_bf16(float lo, float hi) { unsigned r; asm volatile("v_cvt_pk_bf16_f32 %0, %1, %2" : "=v"(r) : "v"(lo), "v"(hi)); return r; }
__device__ __forceinline__ float bf_lo(unsigned w) { return __uint_as_float(w << 16); }
__device__ __forceinline__ float bf_hi(unsigned w) { return __uint_as_float(w & 0xffff0000u); }

struct CopyCtx { const float* src; float* dst; int n, cnt; };
constexpr int CP_LDS_OFF = 131072 + 1024;

template <class Epi, class Sched, bool ALIGN_EPI, bool COPY>
__device__ __forceinline__ void gemm_phase(PG8_LAS unsigned char* lds, const Gemm g, const Sched& S, const Epi& E, const int wid  , CopyCtx& cc) {
    int lane_ = (int)__builtin_amdgcn_mbcnt_hi(~0u, __builtin_amdgcn_mbcnt_lo(~0u, 0u)); asm volatile("" : "+v"(lane_));
    const int lane = lane_, tid = wid * 64 + lane, wr = wid >> 2, wc = wid & 3, fr = lane & 15, fq = lane >> 4;
    const int K = g.K, nt = K / BK;
    unsigned voffA[2], voffB[2];
#pragma unroll
    for (int i = 0; i < 2; ++i) { int R, C; stage_rc(tid * 16 + i * 8192, R, C); const int Rb = Epi::PERM ? ((R & ~31) + perm32(R & 31)) : R;
        voffA[i] = (unsigned)(R * g.lda + C) * 2u; voffB[i] = (unsigned)(Rb * g.ldb + C) * 2u; }
    const size_t kstep = (size_t)(BK * 2);
    const size_t hstepA = (size_t)HALF * g.lda * 2, hstepB = (size_t)HALF * g.ldb * 2;
    const size_t tstepA = 2 * hstepA, tstepB = 2 * hstepB;
    const unsigned ldsw = (unsigned)wid * 1024u;
    const int aoff = lds_byte(wr * 64 + fr, fq * 8), boff = lds_byte(wc * 32 + fr, fq * 8);
#define PG8_SA(b, h) (((b) * 2 + (h)) * HTB)
#define PG8_SB(b, h) ((4 + (b) * 2 + (h)) * HTB)
#define PG8_STAGE(bufoff, gbase, voff) do { _Pragma("unroll") for (int _i = 0; _i < 2; ++_i) \
        __builtin_amdgcn_global_load_lds((const unsigned*)((const char*)(gbase) + (voff)[_i]), (PG8_LAS unsigned*)(lds + (bufoff) + ldsw + _i * 8192), 16, 0, 0); } while (0)
#define PG8_LDA(dst, b, h) do { _Pragma("unroll") for (int m = 0; m < 4; ++m) _Pragma("unroll") for (int k = 0; k < 2; ++k) dst[m][k] = *(const PG8_LAS bf16x8*)(lds + PG8_SA(b, h) + aoff + m * 2048 + k * 1024); } while (0)
#define PG8_LDB(dst, b, h) do { _Pragma("unroll") for (int n = 0; n < 2; ++n) _Pragma("unroll") for (int k = 0; k < 2; ++k) dst[n][k] = *(const PG8_LAS bf16x8*)(lds + PG8_SB(b, h) + boff + n * 2048 + k * 1024); } while (0)
#define PG8_MMA(ai, bj, At, Bt) do { __builtin_amdgcn_s_setprio(1); _Pragma("unroll") for (int m = 0; m < 4; ++m) _Pragma("unroll") for (int n = 0; n < 2; ++n) _Pragma("unroll") for (int k = 0; k < 2; ++k) \
        acc[ai][bj][m][n] = __builtin_amdgcn_mfma_f32_16x16x32_bf16(Bt[n][k], At[m][k], acc[ai][bj][m][n], 0, 0, 0); __builtin_amdgcn_s_setprio(0); } while (0)
#define PG8_WAIT_V(n) asm volatile("s_waitcnt vmcnt(" #n ")" ::: "memory")
#define PG8_WAIT_L(n) asm volatile("s_waitcnt lgkmcnt(" #n ")" ::: "memory")
#define PG8_BAR __builtin_amdgcn_s_barrier()
#define PG8_SCHED __builtin_amdgcn_sched_barrier(0)
#define PG8_APTR(u) ((const char*)g.A + ((size_t)(u).gb * g.bsA) * 2 + (size_t)(u).pm * tstepA)
#define PG8_BPTR(u) ((const char*)g.Bt + ((size_t)(u).gb * g.bsB) * 2 + (size_t)(u).pn * tstepB)
    Unit cur, nxt; int ui = 0;
    if (!S.next(0, cur)) return;
    f32x4 acc[2][2][4][2];
#pragma unroll
    for (int a = 0; a < 2; ++a)
#pragma unroll
        for (int b = 0; b < 2; ++b)
#pragma unroll
            for (int m = 0; m < 4; ++m)
#pragma unroll
                for (int n = 0; n < 2; ++n) acc[a][b][m][n] = (f32x4){0.f, 0.f, 0.f, 0.f};
    bf16x8 At[4][2], B0[2][2], B1[2][2];
    const char* cA = PG8_APTR(cur); const char* cB = PG8_BPTR(cur);
    PG8_STAGE(PG8_SB(0, 0), cB, voffB); PG8_STAGE(PG8_SB(0, 1), cB + hstepB, voffB); PG8_STAGE(PG8_SA(0, 0), cA, voffA); PG8_STAGE(PG8_SA(0, 1), cA + hstepA, voffA);
    if (wr == 1) PG8_BAR;
    PG8_WAIT_V(2); PG8_BAR;
    PG8_STAGE(PG8_SB(1, 0), cB + kstep, voffB); PG8_STAGE(PG8_SA(1, 0), cA + kstep, voffA); PG8_STAGE(PG8_SB(1, 1), cB + hstepB + kstep, voffB);
    PG8_WAIT_V(6); PG8_BAR;
    int cp_k = 0, cp_is = 0, cp_n0 = 0, cp_n1 = 0, cp_n2 = 0, cp_dn = 0; f32x4 cpv = {0.f, 0.f, 0.f, 0.f};
    (void)cp_k; (void)cp_n0; (void)cp_n1; (void)cp_n2; (void)cp_dn; (void)cp_is; (void)cpv;
    for (;;) {
        const bool has_next = S.next(ui + 1, nxt);
        const char* nA = has_next ? PG8_APTR(nxt) : cA; const char* nB = has_next ? PG8_BPTR(nxt) : cB;
        for (int t = 0; t < nt; t += 2) {
            const bool last = (t == nt - 2);
            const char* a1 = cA + (size_t)(t + 1) * kstep;
            const char* a2 = last ? nA : cA + (size_t)(t + 2) * kstep; const char* b2 = last ? nB : cB + (size_t)(t + 2) * kstep;
            const char* a3 = a2 + kstep; const char* b3 = b2 + kstep;
#define PG8_FOUR_SP(W0, W1, W2, W3, CI, D0, D1, D2, D3, T0, T1, T2, T3) \
            PG8_LDB(B0, 0, 0); PG8_LDB(B1, 0, 1); PG8_SCHED; PG8_LDA(At, 0, 0); PG8_STAGE(PG8_SA(1, 1), a1 + hstepA, voffA); CI; \
            PG8_WAIT_V(W0); PG8_WAIT_L(0); PG8_BAR; D0; PG8_MMA(0, 0, At, B0); PG8_MMA(0, 1, At, B1); T0; PG8_BAR; PG8_SCHED; \
            PG8_LDA(At, 0, 1); PG8_STAGE(PG8_SB(0, 0), b2, voffB); PG8_STAGE(PG8_SB(0, 1), b2 + hstepB, voffB); PG8_STAGE(PG8_SA(0, 0), a2, voffA); CI; \
            PG8_WAIT_V(W1); PG8_WAIT_L(0); PG8_BAR; D1; PG8_MMA(1, 0, At, B0); PG8_MMA(1, 1, At, B1); T1; PG8_BAR; PG8_SCHED; \
            PG8_LDB(B0, 1, 0); PG8_LDB(B1, 1, 1); PG8_SCHED; PG8_LDA(At, 1, 0); PG8_STAGE(PG8_SA(0, 1), a2 + hstepA, voffA); CI; \
            PG8_WAIT_V(W2); PG8_WAIT_L(0); PG8_BAR; D2; PG8_MMA(0, 0, At, B0); PG8_MMA(0, 1, At, B1); T2; PG8_BAR; PG8_SCHED; \
            PG8_LDA(At, 1, 1); PG8_STAGE(PG8_SB(1, 0), b3, voffB); PG8_STAGE(PG8_SB(1, 1), b3 + hstepB, voffB); PG8_STAGE(PG8_SA(1, 0), a3, voffA); CI; \
            PG8_WAIT_V(W3); PG8_WAIT_L(0); PG8_BAR; D3; PG8_MMA(1, 0, At, B0); PG8_MMA(1, 1, At, B1); T3; PG8_BAR; PG8_SCHED;
#define PG8_CP_ISSUE do { const int _n = cc.n < cc.cnt ? cc.n : (cc.n - cc.cnt < cc.cnt ? cc.n - cc.cnt : 0); ++cc.n; ++cp_k; \
                __builtin_amdgcn_global_load_lds((const unsigned*)(cc.src + (size_t)_n * 2048 + tid * 4), (PG8_LAS unsigned*)(lds + CP_LDS_OFF + cp_is * 8192 + ldsw), 16, 0, 0); \
                cp_n0 = cp_n1; cp_n1 = cp_n2; cp_n2 = _n; cp_is = cp_is == 2 ? 0 : cp_is + 1; } while (0)
#define PG8_NOP do { } while (0)
#define PG8_CP_DRAIN_LD do { if (cp_k > 2) { cpv = *(const PG8_LAS f32x4*)(lds + CP_LDS_OFF + cp_is * 8192 + ldsw + lane * 16); cp_dn = cp_n0; } } while (0)
#define PG8_CP_DRAIN_ST do { asm volatile("" ::: "memory"); if (cp_k > 2) __builtin_nontemporal_store(cpv, (f32x4*)(cc.dst + (size_t)cp_dn * 2048 + tid * 4)); asm volatile("" ::: "memory"); } while (0)
            if constexpr (COPY) { PG8_FOUR_SP(10, 10, 10, 10, PG8_CP_ISSUE, PG8_CP_DRAIN_LD, PG8_CP_DRAIN_LD, PG8_CP_DRAIN_LD, PG8_CP_DRAIN_LD, PG8_CP_DRAIN_ST, PG8_CP_DRAIN_ST, PG8_CP_DRAIN_ST, PG8_CP_DRAIN_ST) }
            else { PG8_FOUR_SP(8, 8, 8, 8, PG8_NOP, PG8_NOP, PG8_NOP, PG8_NOP, PG8_NOP, PG8_NOP, PG8_NOP, PG8_NOP, PG8_NOP) }
#undef PG8_FOUR_SP
#undef PG8_CP_ISSUE
#undef PG8_NOP
#undef PG8_CP_DRAIN_LD
#undef PG8_CP_DRAIN_ST
        }
        if constexpr (ALIGN_EPI) { if (wr == 0) PG8_BAR; }
        E(acc, cur, wr, wc, fr, fq);
        if (!has_next) break;
#pragma unroll
        for (int a = 0; a < 2; ++a)
#pragma unroll
            for (int b = 0; b < 2; ++b)
#pragma unroll
                for (int m = 0; m < 4; ++m)
#pragma unroll
                    for (int n = 0; n < 2; ++n) acc[a][b][m][n] = (f32x4){0.f, 0.f, 0.f, 0.f};
        cur = nxt; cA = nA; cB = nB; ++ui;
        if constexpr (ALIGN_EPI) { if (wr == 1) PG8_BAR; }
    }
    PG8_WAIT_V(0);
    if constexpr (!ALIGN_EPI) { if (wr == 0) PG8_BAR; }
    PG8_BAR;
    if constexpr (COPY) { if (cp_k >= 2) {
        const int s1 = cp_is == 2 ? 0 : cp_is + 1, s2 = s1 == 2 ? 0 : s1 + 1;
        const f32x4 v1 = *(const PG8_LAS f32x4*)(lds + CP_LDS_OFF + s1 * 8192 + ldsw + lane * 16), v2 = *(const PG8_LAS f32x4*)(lds + CP_LDS_OFF + s2 * 8192 + ldsw + lane * 16);
        __builtin_nontemporal_store(v1, (f32x4*)(cc.dst + (size_t)cp_n1 * 2048 + tid * 4)); __builtin_nontemporal_store(v2, (f32x4*)(cc.dst + (size_t)cp_n2 * 2048 + tid * 4)); } }
#undef PG8_SA
#undef PG8_SB
#undef PG8_STAGE
#undef PG8_LDA
#undef PG8_LDB
#undef PG8_MMA
#undef PG8_WAIT_V
#undef PG8_WAIT_L
#undef PG8_BAR
#undef PG8_SCHED
#undef PG8_APTR
#undef PG8_BPTR
}
}
constexpr int NWAVES = 8;
constexpr int DM = 1024, BP = 8, SEQ = 2048, BS = 128, TS = 4;
constexpr int MP = BP * SEQ, MS = BS * TS, MT = MP + MS;
constexpr int INW = 2048, MIX = 768, NMEM = 256, NG = 48, NP = 64, NC = 16, NH = 12;
constexpr int PRW = 1280;
constexpr int KVW = 3584;
constexpr int UGK = 384;
constexpr float ALPHA = 1.41421356237309515f, LN_EPS = 1e-5f;
constexpr size_t O_Y = 0, O_MEMKV = 17301504, O_SRE_P = 19398656, O_SIM_P = 19423232, O_D1P = 19447808, O_D4P = 19972096,
                 O_D16P = 22069248, O_SRE_S = 30457856, O_SIM_S = 30851072, O_D1S = 31244288, O_D4S = 39632896, O_D16S = 73187328;
constexpr size_t MiB = 1u << 20;
constexpr size_t WS_CTL = 0, CTL_ZERO_BYTES = 1 * MiB;
constexpr size_t WS_WIN0 = 1 * MiB;
constexpr size_t WS_WB1 = 5 * MiB;
constexpr size_t WS_WOUT0 = 12 * MiB;
constexpr size_t WS_WOUT1 = 14 * MiB;
constexpr size_t WS_WGLU = 16 * MiB;
constexpr size_t WS_WMEM = 18 * MiB;
constexpr size_t WS_MEMB = 20 * MiB;
constexpr size_t WS_PT = 24 * MiB;
constexpr size_t WS_TQ = 30 * MiB;
constexpr size_t WS_TAB = 39 * MiB;
constexpr size_t WS_MKVB = 40 * MiB;
constexpr size_t WS_XB = 44 * MiB;
constexpr size_t WS_UGH = 78 * MiB;
constexpr size_t WS_US = 114 * MiB;
constexpr size_t WS_PROJR = 115 * MiB;
constexpr size_t WS_SST = 157 * MiB;
constexpr size_t WS_Y = 181 * MiB;
constexpr size_t WS_A1 = 206 * MiB;
constexpr size_t WS_R = 240 * MiB;
constexpr size_t WS_X1 = 307 * MiB;
constexpr size_t WS_X1B = 374 * MiB;
constexpr size_t WS_KVP = 408 * MiB;
constexpr size_t WS_ATT = 524 * MiB;
constexpr size_t WS_LSE = 549 * MiB;
constexpr size_t WS_END = 551 * MiB;
constexpr int TB_L16R = 0, TB_L16I = 3072, TB_LBR = 6144, TB_LBI = 9216, TB_BBR = 12288, TB_BBI = 12288 + 49152;
constexpr int CW_BAR = 4096;

constexpr int RING_OFF = 0, RING_BYTES = 131072;
constexpr int LDSCTL_OFF = RING_BYTES, MISC_OFF = LDSCTL_OFF + 320;
constexpr int LDS_BYTES = 147456;

#define GAS __attribute__((address_space(1)))
#define LAS __attribute__((address_space(3)))
typedef unsigned short bf16;
typedef unsigned v4u __attribute__((ext_vector_type(4)));
typedef unsigned v2u __attribute__((ext_vector_type(2)));
typedef float f32x4 __attribute__((ext_vector_type(4)));
typedef short bf16x8 __attribute__((ext_vector_type(8)));
typedef GAS unsigned gu32;
#define RLX_AGENT __ATOMIC_RELAXED, __HIP_MEMORY_SCOPE_AGENT
#define LDS_WAIT() asm volatile("s_waitcnt lgkmcnt(0)" ::: "memory")
#define VM_WAIT() asm volatile("s_waitcnt vmcnt(0)" ::: "memory")
__device__ __forceinline__ unsigned f2bf(float f) { unsigned u = __builtin_bit_cast(unsigned, f); return (u + 0x7fffu + ((u >> 16) & 1u)) >> 16; }
__device__ __forceinline__ unsigned pk2(float lo, float hi) { return f2bf(lo) | (f2bf(hi) << 16); }
__device__ __forceinline__ float bf2f(unsigned short h) { return __uint_as_float((unsigned)h << 16); }

__device__ __forceinline__ int lane_id() { int l = (int)__builtin_amdgcn_mbcnt_hi(~0u, __builtin_amdgcn_mbcnt_lo(~0u, 0u)); asm volatile("" : "+v"(l)); return l; }
#define XB_TMO      128
#define XB_XCNT(j)  (256  + 64 * (j))
#define XB_XSUB(j)  (1280 + 64 * (j))
#define XB_XGEN(j)  (2304 + 64 * (j))
#define XB_TOP      3328
#define XB_TOPGEN   3392
#define XCD_BAR_WORDS 3456
#define XB_SPIN_CAP (1u << 18)
__device__ __forceinline__ unsigned xb_ld(unsigned* p)              { return __hip_atomic_load(p, __ATOMIC_RELAXED, __HIP_MEMORY_SCOPE_AGENT); }
__device__ __forceinline__ unsigned xb_add(unsigned* p, unsigned v) { return __hip_atomic_fetch_add(p, v, __ATOMIC_RELAXED, __HIP_MEMORY_SCOPE_AGENT); }
__device__ __forceinline__ unsigned xb_xcc_id() { return (unsigned)__builtin_amdgcn_s_getreg((3 << 11) | 20) & 0xFu; }
#define XB_SPIN(cond, bar) do { unsigned _sp = 0; while (cond) { __builtin_amdgcn_s_sleep(1); \
    if ((++_sp & 255u) == 0u) { if (xb_ld(&(bar)[XB_TMO])) break; if (_sp > XB_SPIN_CAP) { atomicAdd(&(bar)[XB_TMO], 1u); break; } } } } while (0)
struct XcdBarrier { unsigned* bar; unsigned x; volatile LAS unsigned* st; };
__device__ __forceinline__ XcdBarrier xcd_barrier_post(unsigned* bar, volatile LAS unsigned* st, int wave) {
    XcdBarrier b; b.bar = bar; b.x = xb_xcc_id(); b.st = st;
    if (wave == 0 && lane_id() == 0) (void)xb_add(&bar[XB_XCNT(b.x)], 1u);
    return b;
}
__device__ __forceinline__ void xcd_barrier_complete(unsigned* bar, unsigned x, unsigned& nloc, unsigned& nx) {
    const unsigned G = gridDim.x * gridDim.y * gridDim.z;
    unsigned sum, cnt, mine, sp = 0u;
    for (;;) {
        sum = 0u; cnt = 0u; mine = 0u;
#pragma unroll
        for (unsigned j = 0; j < 16; ++j) { const unsigned c = xb_ld(&bar[XB_XCNT(j)]); sum += c; cnt += (c > 0u) ? 1u : 0u; mine = (j == x) ? c : mine; }
        if (sum == G) break;
        __builtin_amdgcn_s_sleep(1);
        if ((++sp & 255u) == 0u) { if (xb_ld(&bar[XB_TMO])) break; if (sp > XB_SPIN_CAP) { atomicAdd(&bar[XB_TMO], 1u); break; } }
    }
    nloc = mine > 0u ? mine : 1u; nx = cnt > 0u ? cnt : 1u;
}
__device__ __forceinline__ void xcd_barrier(const XcdBarrier& b, int wave) {
    asm volatile("s_waitcnt vmcnt(0)" ::: "memory");
    __syncthreads();
    if (wave == 0 && lane_id() == 0) {
        unsigned* bar = b.bar;
        __builtin_amdgcn_s_waitcnt(0);
        unsigned nloc = b.st[0], nx = b.st[1];
        if (nloc == 0u) { xcd_barrier_complete(bar, b.x, nloc, nx); b.st[0] = nloc; b.st[1] = nx; }
        const unsigned old = xb_add(&bar[XB_XSUB(b.x)], 1u);
        const unsigned gen = old / nloc;
        if (old + 1u == (gen + 1u) * nloc) {
            __builtin_amdgcn_fence(__ATOMIC_RELEASE, "agent");
            asm volatile("s_waitcnt vmcnt(0)" ::: "memory");
            const unsigned og = xb_add(&bar[XB_TOP], 1u);
            const unsigned tg = og / nx;
            if (og + 1u == (tg + 1u) * nx) xb_add(&bar[XB_TOPGEN], 1u);
            else XB_SPIN(xb_ld(&bar[XB_TOPGEN]) == tg, bar);
            __builtin_amdgcn_fence(__ATOMIC_ACQUIRE, "agent");
            xb_add(&bar[XB_XGEN(b.x)], 1u);
            asm volatile("s_waitcnt vmcnt(0)" ::: "memory");
        } else {
            XB_SPIN(xb_ld(&bar[XB_XGEN(b.x)]) == gen, bar);
            __builtin_amdgcn_fence(__ATOMIC_ACQUIRE, "agent");
            asm volatile("s_waitcnt vmcnt(0)" ::: "memory");
        }
    }
    __syncthreads();
}

struct Frame {
    LAS unsigned char* lds;
    volatile LAS unsigned* MISC;
    gu32* ctl;
    int wave;
    int vcu, G;
    unsigned char* ws;
    float* out;
    pg8::CopyCtx cc;
};
__device__ __forceinline__ float wave_sum(float v) {
#pragma unroll
    for (int o = 1; o < 64; o <<= 1) v += __shfl_xor(v, o);
    return v;
}
__device__ __forceinline__ float wave_max(float v) {
#pragma unroll
    for (int o = 1; o < 64; o <<= 1) v = fmaxf(v, __shfl_xor(v, o));
    return v;
}
__device__ __forceinline__ int opaque_i(int x) { asm volatile("" : "+v"(x)); return x; }
#define TID_OF(F) ((F).wave * 64 + lane_id())
__device__ __forceinline__ void p0_transpose_item(const float* W, int K, int N, bf16* WT, int row_off, LAS float* scr, int item, int lane) {
    const int nblk = N / 32, kb = item / nblk, nb = item % nblk, k0 = 64 * kb, n0 = 32 * nb;
#pragma unroll 8
    for (int i = 0; i < 32; ++i) { const int kk = 2 * i + (lane >> 5); scr[kk * 33 + (lane & 31)] = W[(size_t)(k0 + kk) * N + n0 + (lane & 31)]; }
    LDS_WAIT(); asm volatile("" ::: "memory");
    const int c = lane & 7;
#pragma unroll
    for (int j = 0; j < 4; ++j) { const int n = (lane >> 3) + 8 * j; const LAS float* s = scr + (8 * c) * 33 + n;
        v4u o; o.x = pk2(s[0 * 33], s[1 * 33]); o.y = pk2(s[2 * 33], s[3 * 33]); o.z = pk2(s[4 * 33], s[5 * 33]); o.w = pk2(s[6 * 33], s[7 * 33]);
        *(GAS v4u*)(WT + (size_t)(row_off + n0 + n) * K + k0 + 8 * c) = o; }
    LDS_WAIT(); asm volatile("" ::: "memory");
}
__device__ __forceinline__ void row_to_bf16(const float* xrow, bf16* orow, int lane) {
    const GAS f32x4* xr = (const GAS f32x4*)xrow + lane;
    GAS unsigned long long* o8 = (GAS unsigned long long*)orow + lane;
#pragma unroll
    for (int j = 0; j < 4; ++j) { const f32x4 v = xr[64 * j]; o8[64 * j] = (unsigned long long)pk2(v.x, v.y) | ((unsigned long long)pk2(v.z, v.w) << 32); }
}
__device__ __forceinline__ void s5_tables_group(int g, const float* lam_re, const float* lam_im, const float* log_dt, const float* b_re, const float* b_im,
                                                const float* c_re, const float* c_im, const float* dsk, bf16* PT, bf16* TQ, float* TAB, LAS float* L, int tid) {
    LAS float* pwr = L;
    LAS float* pwi = L + 1088;
    LAS float* cre = L + 2176;
    LAS float* cim = L + 3200;
    LAS float* bbr = L + 4224;
    LAS float* bbi = L + 5248;
    LAS float* dk = L + 6272;
    LAS float* Kd = L + 6288;
    {
        const int p = tid & 63, dd = tid >> 6, gp = g * 64 + p;
        const double lr = fmin((double)lam_re[gp], -1e-4), li = (double)lam_im[gp], dt = exp((double)log_dt[g]);
        for (int d = dd; d <= 16; d += 8) {
            const double mag = exp((double)d * lr * dt), ang = (double)d * li * dt;
            pwr[d * 64 + p] = (float)(mag * cos(ang)); pwi[d * 64 + p] = (float)(mag * sin(ang));
            if (d == 16) { TAB[TB_L16R + gp] = (float)(mag * cos(ang)); TAB[TB_L16I + gp] = (float)(mag * sin(ang)); }
            if (d == 1) { TAB[TB_LBR + gp] = (float)(mag * cos(ang)); TAB[TB_LBI + gp] = (float)(mag * sin(ang)); }
        }
        if (dd == 0) {
            const double mag = exp(lr * dt), ang = li * dt, zr = mag * cos(ang), zi = mag * sin(ang);
            const double a = zr - 1.0, b = zi, den = lr * lr + li * li;
            const double cr = (a * lr + b * li) / den, ci = (b * lr - a * li) / den;
            for (int c = 0; c < 16; ++c) {
                const double br = b_re[gp * 16 + c], bi = b_im[gp * 16 + c];
                const float vr = (float)(cr * br - ci * bi), vi = (float)(cr * bi + ci * br);
                bbr[p * 16 + c] = vr; bbi[p * 16 + c] = vi;
                TAB[TB_BBR + gp * 16 + c] = vr; TAB[TB_BBI + gp * 16 + c] = vi;
            }
        }
        for (int i = tid; i < 1024; i += 512) { cre[i] = c_re[g * 1024 + i]; cim[i] = c_im[g * 1024 + i]; }
        if (tid < 16) dk[tid] = dsk[g * 16 + tid];
    }
    __syncthreads();
    for (int r = 0; r < 8; ++r) {
        const int idx = tid + 512 * r, d = idx >> 8, c = (idx >> 4) & 15, c2 = idx & 15;
        float s = 0.f;
        for (int p = 0; p < 64; ++p) {
            const float zr = cre[c * 64 + p] * pwr[d * 64 + p] - cim[c * 64 + p] * pwi[d * 64 + p];
            const float zi = cre[c * 64 + p] * pwi[d * 64 + p] + cim[c * 64 + p] * pwr[d * 64 + p];
            s += zr * bbr[p * 16 + c2] - zi * bbi[p * 16 + c2];
        }
        Kd[idx] = s;
    }
    __syncthreads();
    bf16* tq = TQ + (size_t)g * 256 * 384;
    for (int q = tid; q < 256 * 48; q += 512) {
        const int row = q / 48, kc = (q % 48) * 8, j = row >> 4, c = row & 15;
        float v[8];
        if (kc < 256) {
            const int i = kc >> 4, c0 = kc & 15;
#pragma unroll
            for (int e = 0; e < 8; ++e) { float x = 0.f; if (i <= j) { x = Kd[((j - i) << 8) + (c << 4) + c0 + e]; if (i == j && c == c0 + e) x += dk[c]; } v[e] = x; }
        } else {
            const int n0 = kc - 256;
#pragma unroll
            for (int e = 0; e < 8; ++e) { const int n = n0 + e, p = n & 63;
                const float zr = cre[c * 64 + p] * pwr[(j + 1) * 64 + p] - cim[c * 64 + p] * pwi[(j + 1) * 64 + p];
                const float zi = cre[c * 64 + p] * pwi[(j + 1) * 64 + p] + cim[c * 64 + p] * pwr[(j + 1) * 64 + p];
                v[e] = n < 64 ? zr : -zi; }
        }
        v4u o; o.x = pk2(v[0], v[1]); o.y = pk2(v[2], v[3]); o.z = pk2(v[4], v[5]); o.w = pk2(v[6], v[7]);
        *(GAS v4u*)(tq + (size_t)row * 384 + kc) = o;
    }
    bf16* pt = PT + (size_t)g * 256 * 256;
    for (int q = tid; q < 256 * 32; q += 512) {
        const int n = q >> 5, kc = (q & 31) * 8, i = kc >> 4, c0 = kc & 15, p = n & 63;
        float v[8];
#pragma unroll
        for (int e = 0; e < 8; ++e) {
            float x = 0.f;
            if (n < 128) { const float ar = pwr[(15 - i) * 64 + p], ai = pwi[(15 - i) * 64 + p], br = bbr[p * 16 + c0 + e], bi = bbi[p * 16 + c0 + e];
                x = n < 64 ? (ar * br - ai * bi) : (ar * bi + ai * br); }
            v[e] = x;
        }
        v4u o; o.x = pk2(v[0], v[1]); o.y = pk2(v[2], v[3]); o.z = pk2(v[4], v[5]); o.w = pk2(v[6], v[7]);
        *(GAS v4u*)(pt + (size_t)n * 256 + kc) = o;
    }
    __syncthreads();
}
template <int UNR>
__device__ __forceinline__ void copy_cache(const float* buf, float* out, int win, int wg, int nwg, int tid) {
    const long per_b = (long)(win - 4) * 128;
    const long ppb = per_b / 512;
    const long total = ppb * BS;
    for (long p0 = (long)wg * UNR; p0 < total; p0 += (long)nwg * UNR) {
        f32x4 v[UNR];
#pragma unroll
        for (int u = 0; u < UNR; ++u) { const long p = p0 + u; if (p < total) { const long b = p / ppb, r = (p % ppb) * 512 + tid;
            v[u] = __builtin_nontemporal_load((const f32x4*)buf + b * (long)win * 128 + 512 + r); } }
#pragma unroll
        for (int u = 0; u < UNR; ++u) { const long p = p0 + u; if (p < total) { const long b = p / ppb, r = (p % ppb) * 512 + tid;
            __builtin_nontemporal_store(v[u], (f32x4*)out + b * (long)win * 128 + r); } }
    }
}
constexpr int CP_P1 = 128 * 31, CP_P4 = 128 * 127, CP_P16 = 128 * 511, CP_TOTAL = CP_P1 + CP_P4 + CP_P16;
__device__ __forceinline__ void cp_piece_addr(const float* const* in, float* out, int p, const float*& src, float*& dst) {
    if (p < CP_P16) { const int b = p / 511, r = p % 511; const size_t o = (size_t)b * 2048 * 512 + (size_t)r * 2048; src = in[7] + o + 2048; dst = out + O_D16S + o; }
    else if (p < CP_P16 + CP_P4) { const int q = p - CP_P16, b = q / 127, r = q % 127; const size_t o = (size_t)b * 512 * 512 + (size_t)r * 2048; src = in[6] + o + 2048; dst = out + O_D4S + o; }
    else { const int q = p - CP_P16 - CP_P4, b = q / 31, r = q % 31; const size_t o = (size_t)b * 128 * 512 + (size_t)r * 2048; src = in[5] + o + 2048; dst = out + O_D1S + o; }
}
template <int UNR>
__device__ __forceinline__ void copy_pieces(const float* const* in, float* out, int p0, int p1, int w, int nw, int tid) {
    for (int pb = p0 + w; pb < p1; pb += UNR * nw) {
        f32x4 v[UNR];
#pragma unroll
        for (int u = 0; u < UNR; ++u) { const int p = pb + u * nw; if (p < p1) { const float* src; float* dst; cp_piece_addr(in, out, p, src, dst); v[u] = __builtin_nontemporal_load((const f32x4*)(src + tid * 4)); } }
#pragma unroll
        for (int u = 0; u < UNR; ++u) { const int p = pb + u * nw; if (p < p1) { const float* src; float* dst; cp_piece_addr(in, out, p, src, dst); __builtin_nontemporal_store(v[u], (f32x4*)(dst + tid * 4)); } }
    }
}
__device__ __forceinline__ void p0_prologue(Frame& F, const float* const* in) {
    const int gw = F.vcu * NWAVES + F.wave, NGW = F.G * NWAVES;
    const int lane = lane_id();
    if (F.vcu < NG)
        s5_tables_group(F.vcu, in[14], in[15], in[16], in[17], in[18], in[19], in[20], in[21], (bf16*)(F.ws + WS_PT), (bf16*)(F.ws + WS_TQ), (float*)(F.ws + WS_TAB),
                        (LAS float*)(F.lds + RING_OFF), TID_OF(F));
    LAS float* scr = (LAS float*)(F.lds + RING_OFF + F.wave * 16384);
    constexpr int I0 = 16 * 64, I1 = 16 * 48, I2 = 16 * 64, I3 = 16 * 32, I4 = 16 * 32, I5 = 12 * 24, I6 = 16 * 16, I7 = 16 * 16;
    constexpr int NITEMS = I0 + I1 + I2 + I3 + I4 + I5 + I6 + I7;
    const float* w_in = in[9]; const float* w_out = in[10]; const float* w_mem = in[13]; const float* w_glu = in[22]; const float* w_kv = in[24];
    for (int it = gw; it < NITEMS; it += NGW) {
        int r = it;
        if (r < I0) { p0_transpose_item(w_in, 1024, 2048, (bf16*)(F.ws + WS_WIN0), 0, scr, r, lane); continue; } r -= I0;
        if (r < I1) { p0_transpose_item(w_kv, 1024, 1536, (bf16*)(F.ws + WS_WB1), 0, scr, r, lane); continue; } r -= I1;
        if (r < I2) { p0_transpose_item(w_in + (size_t)1024 * 2048, 1024, 2048, (bf16*)(F.ws + WS_WB1), 1536, scr, r, lane); continue; } r -= I2;
        if (r < I3) { p0_transpose_item(w_out, 1024, 1024, (bf16*)(F.ws + WS_WOUT0), 0, scr, r, lane); continue; } r -= I3;
        if (r < I4) { p0_transpose_item(w_out + (size_t)1024 * 1024, 1024, 1024, (bf16*)(F.ws + WS_WOUT1), 0, scr, r, lane); continue; } r -= I4;
        if (r < I5) { p0_transpose_item(w_glu, 768, 768, (bf16*)(F.ws + WS_WGLU), 0, scr, r, lane); continue; } r -= I5;
        if (r < I6) { p0_transpose_item(w_mem, 1024, 512, (bf16*)(F.ws + WS_WMEM), 0, scr, r, lane); continue; } r -= I6;
        p0_transpose_item(w_mem + (size_t)1024 * 512, 1024, 512, (bf16*)(F.ws + WS_WMEM), 512, scr, r, lane);
    }
    for (int m = gw; m < MT + BP * NMEM; m += NGW) {
        if (m < MP) row_to_bf16(in[0] + (size_t)m * DM, (bf16*)(F.ws + WS_XB) + (size_t)m * DM, lane);
        else if (m < MT) row_to_bf16(in[1] + (size_t)(m - MP) * DM, (bf16*)(F.ws + WS_XB) + (size_t)m * DM, lane);
        else row_to_bf16(in[8] + (size_t)(m - MT) * DM, (bf16*)(F.ws + WS_MEMB) + (size_t)(m - MT) * DM, lane);
    }
}

struct EpiProj0 {
    static constexpr bool PERM = true;
    bf16* UGH; bf16* US; bf16* PROJR;
    __device__ __forceinline__ void operator()(const pg8::f32x4 (&acc)[2][2][4][2], const pg8::Unit& u, int wr, int wc, int fr, int fq) const {
        const int row0 = u.pm * 256 + wr * 64 + fr, col0 = u.pn * 256 + wc * 32 + 8 * fq;
#pragma unroll
        for (int ai = 0; ai < 2; ++ai)
#pragma unroll
            for (int m = 0; m < 4; ++m) {
                const int row = row0 + ai * 128 + m * 16;
#pragma unroll
                for (int bj = 0; bj < 2; ++bj) {
                    const int col = col0 + bj * 128;
                    const pg8::f32x4 v0 = acc[ai][bj][m][0], v1 = acc[ai][bj][m][1];
                    pg8::u32x4 w; w.x = pg8::cvt_pk_bf16(v0[0], v0[1]); w.y = pg8::cvt_pk_bf16(v0[2], v0[3]); w.z = pg8::cvt_pk_bf16(v1[0], v1[1]); w.w = pg8::cvt_pk_bf16(v1[2], v1[3]);
                    bf16* dst;
                    if (u.pn < 3) {
                        if (u.pm < 64) { const int b = row >> 11, t = row & 2047, g = col >> 4;
                            dst = UGH + ((size_t)(g * 1024 + b * 128 + (t >> 4)) * UGK + (t & 15) * 16 + (col & 15)); }
                        else dst = US + (size_t)(row - MP) * MIX + col;
                    } else dst = PROJR + (size_t)row * PRW + (col - MIX);
                    *(pg8::u32x4*)dst = w;
                }
            }
    }
};
struct EpiMemKV {
    static constexpr bool PERM = false;
    float* out; bf16* MKVB;
    __device__ __forceinline__ void operator()(const pg8::f32x4 (&acc)[2][2][4][2], const pg8::Unit& u, int wr, int wc, int fr, int fq) const {
        const int row0 = u.pm * 256 + wr * 64 + fr, col0 = u.pn * 256 + wc * 32 + 4 * fq;
#pragma unroll
        for (int ai = 0; ai < 2; ++ai)
#pragma unroll
            for (int m = 0; m < 4; ++m) {
                const int row = row0 + ai * 128 + m * 16;
#pragma unroll
                for (int bj = 0; bj < 2; ++bj)
#pragma unroll
                    for (int n = 0; n < 2; ++n) {
                        const int col = col0 + bj * 128 + n * 16, l = col >> 9, k = col & 511;
                        const size_t idx = ((size_t)l * 2048 + row) * 512 + k;
                        const pg8::f32x4 v = acc[ai][bj][m][n];
                        *(pg8::f32x4*)(out + O_MEMKV + idx) = v;
                        pg8::u32x2 w; w.x = pg8::cvt_pk_bf16(v[0], v[1]); w.y = pg8::cvt_pk_bf16(v[2], v[3]);
                        *(pg8::u32x2*)(MKVB + idx) = w;
                    }
            }
    }
};
__device__ __forceinline__ float fast_sigmoid(float x) { return __builtin_amdgcn_rcpf(1.f + __builtin_amdgcn_exp2f(-1.4426950408889634f * x)); }
__device__ __forceinline__ float fast_silu(float x) { return x * fast_sigmoid(x); }
__device__ __forceinline__ float fast_gelu_tanh(float x) { const float z = 0.7978845608028654f * (x + 0.044715f * x * x * x); return x * fast_sigmoid(2.f * z); }
struct EpiS {
    static constexpr bool PERM = false;
    float* SST;
    __device__ __forceinline__ void operator()(const pg8::f32x4 (&acc)[2][2][4][2], const pg8::Unit& u, int wr, int wc, int fr, int fq) const {
        const int row0 = u.pm * 256 + wr * 64 + fr, col0 = wc * 32 + 4 * fq;
#pragma unroll
        for (int ai = 0; ai < 2; ++ai)
#pragma unroll
            for (int m = 0; m < 4; ++m) {
                const int row = row0 + ai * 128 + m * 16;
#pragma unroll
                for (int n = 0; n < 2; ++n) *(pg8::f32x4*)(SST + ((size_t)(u.gb * 1024 + row) * 128 + col0 + n * 16)) = acc[ai][0][m][n];
            }
    }
};
__device__ __forceinline__ void s5_carry_scan(const pg8::Unit& u, const float* __restrict__ SST, bf16* __restrict__ UGH, const float* __restrict__ TAB, float* __restrict__ out, int tid) {
    if (tid < 128) {
        const int bl = tid >> 6, p = tid & 63, g = u.gb, b = 2 * u.pm + bl;
        const float lr = TAB[TB_L16R + g * 64 + p], li = TAB[TB_L16I + g * 64 + p];
        float hr = 0.f, hi = 0.f;
        const float* s = SST + (size_t)(g * 1024 + b * 128) * 128 + p;
        bf16* h = UGH + (size_t)(g * 1024 + b * 128) * UGK + 256 + p;
        float cr[16], ci[16], nr_[16], ni_[16];
#pragma unroll
        for (int j = 0; j < 16; ++j) { cr[j] = s[(size_t)j * 128]; ci[j] = s[(size_t)j * 128 + 64]; }
#pragma unroll 1
        for (int k0 = 0; k0 < 128; k0 += 16) {
            if (k0 + 16 < 128) {
#pragma unroll
                for (int j = 0; j < 16; ++j) { nr_[j] = s[(size_t)(k0 + 16 + j) * 128]; ni_[j] = s[(size_t)(k0 + 16 + j) * 128 + 64]; }
            }
#pragma unroll
            for (int j = 0; j < 16; ++j) {
                h[(size_t)(k0 + j) * UGK] = (bf16)f2bf(hr); h[(size_t)(k0 + j) * UGK + 64] = (bf16)f2bf(hi);
                const float nr = lr * hr - li * hi + cr[j], ni = lr * hi + li * hr + ci[j];
                hr = nr; hi = ni;
            }
#pragma unroll
            for (int j = 0; j < 16; ++j) { cr[j] = nr_[j]; ci[j] = ni_[j]; }
        }
        out[O_SRE_P + (size_t)(b * 48 + g) * 64 + p] = hr; out[O_SIM_P + (size_t)(b * 48 + g) * 64 + p] = hi;
    }
}
struct EpiY {
    static constexpr bool PERM = true;
    bf16* Y;
    __device__ __forceinline__ void operator()(const pg8::f32x4 (&acc)[2][2][4][2], const pg8::Unit& u, int wr, int wc, int fr, int fq) const {
        const int row0 = u.pm * 256 + wr * 64 + fr, col0 = wc * 32 + 8 * fq;
#pragma unroll
        for (int ai = 0; ai < 2; ++ai)
#pragma unroll
            for (int m = 0; m < 4; ++m) {
                const int R = row0 + ai * 128 + m * 16, b = R >> 7, k = R & 127;
#pragma unroll
                for (int bj = 0; bj < 2; ++bj) {
                    const int col = col0 + bj * 128, j = col >> 4, c0 = col & 15;
                    const pg8::f32x4 v0 = acc[ai][bj][m][0], v1 = acc[ai][bj][m][1];
                    pg8::u32x4 w;
                    w.x = pg8::cvt_pk_bf16(fast_gelu_tanh(v0[0]), fast_gelu_tanh(v0[1])); w.y = pg8::cvt_pk_bf16(fast_gelu_tanh(v0[2]), fast_gelu_tanh(v0[3]));
                    w.z = pg8::cvt_pk_bf16(fast_gelu_tanh(v1[0]), fast_gelu_tanh(v1[1])); w.w = pg8::cvt_pk_bf16(fast_gelu_tanh(v1[2]), fast_gelu_tanh(v1[3]));
                    *(pg8::u32x4*)(Y + ((size_t)(b * 2048 + k * 16 + j) * MIX + u.gb * 16 + c0)) = w;
                }
            }
    }
};
__device__ __forceinline__ void s5_sample_task(int b, int g, const float* const* in, const float* TAB, const bf16* US, bf16* Y, float* out, int lane) {
    const int gp = g * 64 + lane;
    const float lr = TAB[TB_LBR + gp], li = TAB[TB_LBI + gp];
    float br[16], bi[16], cr[16], ci[16];
#pragma unroll
    for (int q = 0; q < 4; ++q) { const f32x4 a = *(const f32x4*)(TAB + TB_BBR + gp * 16 + 4 * q), c = *(const f32x4*)(TAB + TB_BBI + gp * 16 + 4 * q);
        br[4 * q] = a.x; br[4 * q + 1] = a.y; br[4 * q + 2] = a.z; br[4 * q + 3] = a.w; bi[4 * q] = c.x; bi[4 * q + 1] = c.y; bi[4 * q + 2] = c.z; bi[4 * q + 3] = c.w; }
#pragma unroll
    for (int c = 0; c < 16; ++c) { cr[c] = in[19][(size_t)(g * 16 + c) * 64 + lane]; ci[c] = in[20][(size_t)(g * 16 + c) * 64 + lane]; }
    float hr = in[3][(size_t)(b * 48 + g) * 64 + lane], hi = in[4][(size_t)(b * 48 + g) * 64 + lane];
    float v[64];
#pragma unroll
    for (int t = 0; t < 4; ++t) {
        const bf16* up = US + (size_t)(b * 4 + t) * MIX + g * 16;
        const v4u u0 = *(const v4u*)up, u1 = *(const v4u*)(up + 8);
        float uu[16];
        uu[0] = pg8::bf_lo(u0.x); uu[1] = pg8::bf_hi(u0.x); uu[2] = pg8::bf_lo(u0.y); uu[3] = pg8::bf_hi(u0.y); uu[4] = pg8::bf_lo(u0.z); uu[5] = pg8::bf_hi(u0.z); uu[6] = pg8::bf_lo(u0.w); uu[7] = pg8::bf_hi(u0.w);
        uu[8] = pg8::bf_lo(u1.x); uu[9] = pg8::bf_hi(u1.x); uu[10] = pg8::bf_lo(u1.y); uu[11] = pg8::bf_hi(u1.y); uu[12] = pg8::bf_lo(u1.z); uu[13] = pg8::bf_hi(u1.z); uu[14] = pg8::bf_lo(u1.w); uu[15] = pg8::bf_hi(u1.w);
        float bur = 0.f, bui = 0.f;
#pragma unroll
        for (int c = 0; c < 16; ++c) { bur += br[c] * uu[c]; bui += bi[c] * uu[c]; }
        const float nr = lr * hr - li * hi + bur, ni = lr * hi + li * hr + bui;
        hr = nr; hi = ni;
#pragma unroll
        for (int c = 0; c < 16; ++c) v[t * 16 + c] = cr[c] * hr - ci[c] * hi;
    }
    out[O_SRE_S + (size_t)(b * 48 + g) * 64 + lane] = hr; out[O_SIM_S + (size_t)(b * 48 + g) * 64 + lane] = hi;
#define TR_STEP(N, MSK, SH) { const bool bit = (lane >> SH) & 1; _Pragma("unroll") for (int i = 0; i < N / 2; ++i) { const float send = bit ? v[i] : v[i + N / 2]; const float keep = bit ? v[i + N / 2] : v[i]; v[i] = keep + __shfl_xor(send, MSK); } }
    TR_STEP(64, 32, 5) TR_STEP(32, 16, 4) TR_STEP(16, 8, 3) TR_STEP(8, 4, 2) TR_STEP(4, 2, 1) TR_STEP(2, 1, 0)
#undef TR_STEP
    const int t = lane >> 4, c = lane & 15;
    const float uv = bf2f(US[(size_t)(b * 4 + t) * MIX + g * 16 + c]);
    const float y = v[0] + in[21][g * 16 + c] * uv;
    Y[(size_t)(MP + b * 4 + t) * MIX + g * 16 + c] = (bf16)f2bf(fast_gelu_tanh(y));
}
struct EpiGlu {
    static constexpr bool PERM = true;
    const bf16* Y; const bf16* PROJR; const float* b_glu; bf16* A1;
    __device__ __forceinline__ void operator()(const pg8::f32x4 (&acc)[2][2][4][2], const pg8::Unit& u, int wr, int wc, int fr, int fq) const {
        const int row0 = u.pm * 256 + wr * 64 + fr, col0 = u.pn * 256 + wc * 32 + 8 * fq;
#pragma unroll
        for (int bj = 0; bj < 2; ++bj) {
            const int col = col0 + bj * 128;
            const pg8::f32x4 b0 = *(const pg8::f32x4*)(b_glu + col), b1 = *(const pg8::f32x4*)(b_glu + col + 4);
#pragma unroll
            for (int ai = 0; ai < 2; ++ai)
#pragma unroll
                for (int m = 0; m < 4; ++m) {
                    const int row = row0 + ai * 128 + m * 16;
                    const pg8::u32x4 yv = *(const pg8::u32x4*)(Y + (size_t)row * MIX + col);
                    const pg8::u32x4 gv = *(const pg8::u32x4*)(PROJR + (size_t)row * PRW + col);
                    const pg8::f32x4 z0 = acc[ai][bj][m][0] + b0, z1 = acc[ai][bj][m][1] + b1;
                    float o[8];
                    o[0] = pg8::bf_lo(yv.x) * fast_sigmoid(z0[0]) * fast_silu(pg8::bf_lo(gv.x)); o[1] = pg8::bf_hi(yv.x) * fast_sigmoid(z0[1]) * fast_silu(pg8::bf_hi(gv.x));
                    o[2] = pg8::bf_lo(yv.y) * fast_sigmoid(z0[2]) * fast_silu(pg8::bf_lo(gv.y)); o[3] = pg8::bf_hi(yv.y) * fast_sigmoid(z0[3]) * fast_silu(pg8::bf_hi(gv.y));
                    o[4] = pg8::bf_lo(yv.z) * fast_sigmoid(z1[0]) * fast_silu(pg8::bf_lo(gv.z)); o[5] = pg8::bf_hi(yv.z) * fast_sigmoid(z1[1]) * fast_silu(pg8::bf_hi(gv.z));
                    o[6] = pg8::bf_lo(yv.w) * fast_sigmoid(z1[2]) * fast_silu(pg8::bf_lo(gv.w)); o[7] = pg8::bf_hi(yv.w) * fast_sigmoid(z1[3]) * fast_silu(pg8::bf_hi(gv.w));
                    pg8::u32x4 w; w.x = pg8::cvt_pk_bf16(o[0], o[1]); w.y = pg8::cvt_pk_bf16(o[2], o[3]); w.z = pg8::cvt_pk_bf16(o[4], o[5]); w.w = pg8::cvt_pk_bf16(o[6], o[7]);
                    *(pg8::u32x4*)(A1 + (size_t)row * DM + col) = w;
                }
        }
    }
};

typedef float f32x16 __attribute__((ext_vector_type(16)));
typedef short v4i16_t __attribute__((ext_vector_type(4)));
__device__ __forceinline__ void pv_tile(f32x16 (&o)[2], const f32x16& p, const LAS unsigned char* vl, int lane) {
    const int hh = lane >> 5, gq = lane >> 4, q = (lane & 15) >> 2, pp = lane & 3;
    const LAS unsigned char* base = vl + (4 * hh + q) * 128 + (16 * (gq & 1) + 4 * pp) * 2;
#pragma unroll
    for (int s = 0; s < 2; ++s) {
        pg8::u32x4 pw; pw.x = pg8::cvt_pk_bf16(p[8 * s + 0], p[8 * s + 1]); pw.y = pg8::cvt_pk_bf16(p[8 * s + 2], p[8 * s + 3]);
        pw.z = pg8::cvt_pk_bf16(p[8 * s + 4], p[8 * s + 5]); pw.w = pg8::cvt_pk_bf16(p[8 * s + 6], p[8 * s + 7]);
        const bf16x8 pa = __builtin_bit_cast(bf16x8, pw);
#pragma unroll
        for (int db = 0; db < 2; ++db) {
            const v4i16_t lo = __builtin_amdgcn_ds_read_tr16_b64_v4i16((LAS v4i16_t*)(base + (16 * s) * 128 + db * 64));
            const v4i16_t hi = __builtin_amdgcn_ds_read_tr16_b64_v4i16((LAS v4i16_t*)(base + (16 * s + 8) * 128 + db * 64));
            const bf16x8 vf = (bf16x8){lo[0], lo[1], lo[2], lo[3], hi[0], hi[1], hi[2], hi[3]};
            o[db] = __builtin_amdgcn_mfma_f32_32x32x16_bf16(pa, vf, o[db], 0, 0, 0);
        }
    }
}
__device__ __forceinline__ float half_max(float v) { return fmaxf(v, __shfl_xor(v, 32)); }
__device__ __forceinline__ float half_sum(float v) { return v + __shfl_xor(v, 32); }
__device__ __forceinline__ void load_kfrag(bf16x8 (&kf)[4], const bf16* krow, int hh) {
#pragma unroll
    for (int ks = 0; ks < 4; ++ks) kf[ks] = *(const bf16x8*)(krow + 16 * ks + 8 * hh);
}
__device__ __forceinline__ f32x16 qk_mma(const bf16x8 (&kf)[4], const bf16x8 (&qf)[4]) {
    f32x16 acc = {};
#pragma unroll
    for (int ks = 0; ks < 4; ++ks) acc = __builtin_amdgcn_mfma_f32_32x32x16_bf16(kf[ks], qf[ks], acc, 0, 0, 0);
    return acc;
}
template <class VRow> __device__ __forceinline__ void load_v_tile(v4u (&tmp)[4], const VRow& vrow, int lane) {
#pragma unroll
    for (int i = 0; i < 4; ++i) { const int piece = lane + 64 * i, key = piece >> 3, ch = piece & 7; tmp[i] = *(const v4u*)(vrow(key) + ch * 8); }
}
__device__ __forceinline__ void write_v_tile(LAS unsigned char* vl, const v4u (&tmp)[4], int lane) {
#pragma unroll
    for (int i = 0; i < 4; ++i) *(LAS v4u*)(vl + (lane + 64 * i) * 16) = tmp[i];
}
__device__ __forceinline__ float red16(float d) { d += __shfl_xor(d, 1); d += __shfl_xor(d, 2); d += __shfl_xor(d, 4); d += __shfl_xor(d, 8); return d; }
__device__ __forceinline__ float max16(float d) { d = fmaxf(d, __shfl_xor(d, 1)); d = fmaxf(d, __shfl_xor(d, 2)); d = fmaxf(d, __shfl_xor(d, 4)); d = fmaxf(d, __shfl_xor(d, 8)); return d; }
__device__ __forceinline__ f32x4 bf4_to_f4(v2u w) { return (f32x4){pg8::bf_lo(w.x), pg8::bf_hi(w.x), pg8::bf_lo(w.y), pg8::bf_hi(w.y)}; }
constexpr int SCP = 264;

__device__ __forceinline__ void mem_attn_prompt_task(int b, int h, int qblk, const bf16* qbase, const bf16* gbase, int qpitch, const bf16* mkv  ,
                                                     bf16* A1, LAS unsigned char* vl, int lane_in) {
    const int lane = lane_id(); (void)lane_in;
    const int qi = lane & 31, hh = lane >> 5;
    const size_t qrow = (size_t)b * SEQ + qblk * 32 + qi;
    bf16x8 qf[4];
#pragma unroll
    for (int ks = 0; ks < 4; ++ks) qf[ks] = *(const bf16x8*)(qbase + qrow * qpitch + h * 64 + 16 * ks + 8 * hh);
    const bf16* kb = mkv + (size_t)qi * 512 + h * 64;
    float mx = -1e30f;
    {
        bf16x8 kf[4], kn[4];
        load_kfrag(kf, kb, hh);
#pragma unroll 1
        for (int kt = 0; kt < 8; ++kt) {
            if (kt + 1 < 8) load_kfrag(kn, kb + (size_t)(kt + 1) * 32 * 512, hh);
            const f32x16 st = qk_mma(kf, qf);
#pragma unroll
            for (int r = 0; r < 16; ++r) mx = fmaxf(mx, st[r]);
#pragma unroll
            for (int ks = 0; ks < 4; ++ks) kf[ks] = kn[ks];
        }
    }
    mx = half_max(mx);
    const float c2 = 0.125f * 1.4426950408889634f;
    float l = 0.f;
    f32x16 o[2] = {};
    {
        bf16x8 kf[4], kn[4]; v4u vt[4], vn[4];
        load_kfrag(kf, kb, hh);
        load_v_tile(vt, [&](int key) { return mkv + (size_t)key * 512 + 256 + h * 64; }, lane);
#pragma unroll 1
        for (int kt = 0; kt < 8; ++kt) {
            if (kt + 1 < 8) { load_kfrag(kn, kb + (size_t)(kt + 1) * 32 * 512, hh);
                              load_v_tile(vn, [&](int key) { return mkv + (size_t)((kt + 1) * 32 + key) * 512 + 256 + h * 64; }, lane); }
            f32x16 st = qk_mma(kf, qf);
#pragma unroll
            for (int r = 0; r < 16; ++r) { const float e = __builtin_amdgcn_exp2f((st[r] - mx) * c2); st[r] = e; l += e; }
            write_v_tile(vl, vt, lane);
            LDS_WAIT();
            pv_tile(o, st, vl, lane);
            LDS_WAIT();
#pragma unroll
            for (int ks = 0; ks < 4; ++ks) { kf[ks] = kn[ks]; vt[ks] = vn[ks]; }
        }
    }
    l = half_sum(l);
    const float il = 1.f / l;
#pragma unroll
    for (int r = 0; r < 16; ++r) {
        const int q = (r & 3) + 8 * (r >> 2) + 4 * hh;
        const float ilq = __shfl(il, q);
        const size_t row = (size_t)b * SEQ + qblk * 32 + q;
#pragma unroll
        for (int db = 0; db < 2; ++db) {
            const int d = db * 32 + qi;
            const float gate = bf2f(gbase[row * qpitch + h * 64 + d]);
            A1[row * DM + MIX + h * 64 + d] = (bf16)f2bf(o[db][r] * ilq * fast_silu(gate));
        }
    }
}
__device__ __forceinline__ void mem_attn_sample_wg(int b, const bf16* qbase, const bf16* gbase, int qpitch, const float* cache_l  ,
                                                   bf16* A1, LAS float* scs, LAS f32x4* red, int wave) {
    const int lane = lane_id();
    const size_t row0 = (size_t)MP + b * TS;
    const float* kvu = cache_l + (size_t)b * NMEM * 512 + (size_t)wave * 512;
    const int l4 = lane * 4, li = lane & 15, hd = lane >> 4;
    const float c2 = 0.125f * 1.4426950408889634f;
    f32x4 q4[TS];
#pragma unroll
    for (int t = 0; t < TS; ++t) { q4[t] = bf4_to_f4(*(const v2u*)(qbase + (row0 + t) * qpitch + l4)); q4[t] = q4[t] * c2; }
    {
        f32x4 kk[32];
#pragma unroll
        for (int i = 0; i < 32; ++i) kk[i] = *(const f32x4*)(kvu + (size_t)i * 8 * 512 + l4);
#pragma unroll
        for (int i = 0; i < 32; ++i)
#pragma unroll
            for (int t = 0; t < TS; ++t) { const float d = red16(q4[t].x * kk[i].x + q4[t].y * kk[i].y + q4[t].z * kk[i].z + q4[t].w * kk[i].w);
                if (li == ((i * TS + t) & 15)) scs[(t * 4 + hd) * SCP + wave + 8 * i] = d; }
    }
    LDS_WAIT(); __syncthreads();
    float mx[TS], sum[TS];
#pragma unroll
    for (int t = 0; t < TS; ++t) {
        const LAS float* sch = scs + (t * 4 + hd) * SCP;
        float m_ = -1e30f;
#pragma unroll
        for (int i = 0; i < NMEM / 16; ++i) m_ = fmaxf(m_, sch[li + 16 * i]);
        m_ = max16(m_);
        float s_ = 0.f;
#pragma unroll
        for (int i = 0; i < NMEM / 16; ++i) s_ += __builtin_amdgcn_exp2f(sch[li + 16 * i] - m_);
        mx[t] = m_; sum[t] = red16(s_);
    }
    f32x4 o4[TS];
#pragma unroll
    for (int t = 0; t < TS; ++t) o4[t] = (f32x4){0.f, 0.f, 0.f, 0.f};
    {
        f32x4 vv[32];
#pragma unroll
        for (int i = 0; i < 32; ++i) vv[i] = *(const f32x4*)(kvu + (size_t)i * 8 * 512 + 256 + l4);
#pragma unroll
        for (int i = 0; i < 32; ++i)
#pragma unroll
            for (int t = 0; t < TS; ++t) o4[t] = o4[t] + vv[i] * __builtin_amdgcn_exp2f(scs[(t * 4 + hd) * SCP + wave + 8 * i] - mx[t]);
    }
#pragma unroll
    for (int t = 0; t < TS; ++t) red[(wave * TS + t) * 64 + lane] = o4[t];
    LDS_WAIT(); __syncthreads();
    if (wave < TS) {
        f32x4 o = red[wave * 64 + lane];
#pragma unroll
        for (int w = 1; w < 8; ++w) o = o + red[(w * TS + wave) * 64 + lane];
        float sm = sum[0];
#pragma unroll
        for (int t = 1; t < TS; ++t) sm = wave == t ? sum[t] : sm;
        const float inv = 1.f / sm;
        const size_t row = row0 + wave;
        const f32x4 g4 = bf4_to_f4(*(const v2u*)(gbase + row * qpitch + l4));
        v2u w2; w2.x = pk2(o.x * inv * fast_silu(g4.x), o.y * inv * fast_silu(g4.y)); w2.y = pk2(o.z * inv * fast_silu(g4.z), o.w * inv * fast_silu(g4.w));
        *(v2u*)(A1 + row * DM + MIX + l4) = w2;
    }
    LDS_WAIT(); __syncthreads();
}
constexpr int NSW = 128;
__device__ __forceinline__ void mem_attn_phase(Frame& F, int flags, int layer, const bf16* qbase, const bf16* gbase, int qpitch, const float* cache_mem, bf16* A1) {
    LDS_WAIT(); __syncthreads();
    const bool two_roles = F.G > NSW;
    if (!two_roles || F.vcu < NSW) {
        if (!(flags & 2))
        for (int b = F.vcu; b < BS; b += (two_roles ? NSW : F.G))
            mem_attn_sample_wg(b, qbase, gbase, qpitch, cache_mem + (size_t)layer * BS * NMEM * 512, A1, (LAS float*)(F.lds + RING_OFF), (LAS f32x4*)(F.lds + RING_OFF + 20480), F.wave);
    }
    if (!two_roles || F.vcu >= NSW) {
        const int nwg = two_roles ? F.G - NSW : F.G, wgi = two_roles ? F.vcu - NSW : F.vcu;
        const int gw = wgi * NWAVES + F.wave, NGW = nwg * NWAVES;
        LAS unsigned char* wl = F.lds + RING_OFF + F.wave * 16384;
        const bf16* mkvb = (const bf16*)(F.ws + WS_MKVB) + (size_t)layer * BP * NMEM * 512;
        constexpr int NT_P = BP * 4 * (SEQ / 32);
        if (!(flags & 4))
        for (int tp = gw; tp < NT_P; tp += NGW) {
            const int qblk = tp % (SEQ / 32), bh = tp / (SEQ / 32), h = bh & 3, b = bh >> 2;
            mem_attn_prompt_task(b, h, qblk, qbase, gbase, qpitch, mkvb + (size_t)b * NMEM * 512, A1, wl, 0);
        }
    }
}
struct EpiR {
    static constexpr bool PERM = false;
    const float* xa; const float* xb; float* R;
    __device__ __forceinline__ void operator()(const pg8::f32x4 (&acc)[2][2][4][2], const pg8::Unit& u, int wr, int wc, int fr, int fq) const {
        const int row0 = u.pm * 256 + wr * 64 + fr, col0 = u.pn * 256 + wc * 32 + 4 * fq;
        const float* xs = u.pm < 64 ? xa + (size_t)row0 * DM : xb + (size_t)(row0 - MP) * DM;
#pragma unroll
        for (int ai = 0; ai < 2; ++ai)
#pragma unroll
            for (int m = 0; m < 4; ++m) {
                const size_t ro = (size_t)(ai * 128 + m * 16) * DM;
#pragma unroll
                for (int bj = 0; bj < 2; ++bj)
#pragma unroll
                    for (int n = 0; n < 2; ++n) {
                        const int col = col0 + bj * 128 + n * 16;
                        const pg8::f32x4 xv = *(const pg8::f32x4*)(xs + ro + col);
                        *(pg8::f32x4*)(R + (size_t)row0 * DM + ro + col) = xv * ALPHA + acc[ai][bj][m][n];
                    }
            }
    }
};
__device__ __forceinline__ void ln_phase(Frame& F, const float* R, const float* gam, const float* bet, float* o32, bf16* ob) {
    const int gw = F.vcu * NWAVES + F.wave, NGW = F.G * NWAVES;
    const int lane_ = lane_id();
    f32x4 gv[4], bv[4];
#pragma unroll
    for (int j = 0; j < 4; ++j) { gv[j] = *((const f32x4*)gam + lane_ + 64 * j); bv[j] = *((const f32x4*)bet + lane_ + 64 * j); }
    for (int m = gw; m < MT; m += NGW) {
        const f32x4* xr = (const f32x4*)(R + (size_t)m * DM) + lane_;
        f32x4 v[4]; float s = 0.f;
#pragma unroll
        for (int j = 0; j < 4; ++j) { v[j] = xr[64 * j]; s += (v[j].x + v[j].y) + (v[j].z + v[j].w); }
        const float mean = wave_sum(s) * (1.f / DM); float s2 = 0.f;
#pragma unroll
        for (int j = 0; j < 4; ++j) { v[j] = v[j] - mean; s2 += (v[j].x * v[j].x + v[j].y * v[j].y) + (v[j].z * v[j].z + v[j].w * v[j].w); }
        const float rstd = 1.f / sqrtf(wave_sum(s2) * (1.f / DM) + LN_EPS);
#pragma unroll
        for (int j = 0; j < 4; ++j) {
            const f32x4 o = v[j] * rstd * gv[j] + bv[j];
            *((f32x4*)(o32 + (size_t)m * DM) + lane_ + 64 * j) = o;
            if (ob) { v2u w; w.x = pk2(o.x, o.y); w.y = pk2(o.z, o.w); *((v2u*)(ob + (size_t)m * DM) + lane_ + 64 * j) = w; }
        }
    }
}
struct EpiKVQ {
    static constexpr bool PERM = true;
    bf16* KVP; float* out;
    __device__ __forceinline__ void operator()(const pg8::f32x4 (&acc)[2][2][4][2], const pg8::Unit& u, int wr, int wc, int fr, int fq) const {
        const int row0 = u.pm * 256 + wr * 64 + fr, colt = wc * 32 + 8 * fq;
        const bool iskv = u.pn < 6;
        const int s = u.pn >= 3 ? 1 : 0, g = u.pn - 3 * s;
        const int win = g == 0 ? 128 : (g == 1 ? 512 : 2048);
        const size_t obase_p = g == 0 ? O_D1P : (g == 1 ? O_D4P : O_D16P), obase_s = g == 0 ? O_D1S : (g == 1 ? O_D4S : O_D16S);
#pragma unroll
        for (int ai = 0; ai < 2; ++ai)
#pragma unroll
            for (int m = 0; m < 4; ++m) {
                const int row = row0 + ai * 128 + m * 16;
#pragma unroll
                for (int bj = 0; bj < 2; ++bj) {
                    const int ct = colt + bj * 128;
                    const pg8::f32x4 v0 = acc[ai][bj][m][0], v1 = acc[ai][bj][m][1];
                    pg8::u32x4 w; w.x = pg8::cvt_pk_bf16(v0[0], v0[1]); w.y = pg8::cvt_pk_bf16(v0[2], v0[3]); w.z = pg8::cvt_pk_bf16(v1[0], v1[1]); w.w = pg8::cvt_pk_bf16(v1[2], v1[3]);
                    *(pg8::u32x4*)(KVP + (size_t)row * KVW + u.pn * 256 + ct) = w;
                    if (iskv) {
                        float* dst = nullptr;
                        if (u.pm < 64) { const int b = row >> 11, t = row & 2047;
                            if (t >= SEQ - win) dst = out + obase_p + ((size_t)(b * win + (t - (SEQ - win))) * 2 + s) * 256 + ct; }
                        else { const int rs = row - MP, b = rs >> 2, t = rs & 3;
                            dst = out + obase_s + ((size_t)(b * win + (win - 4 + t)) * 2 + s) * 256 + ct; }
                        if (dst) { *(pg8::f32x4*)dst = v0; *(pg8::f32x4*)(dst + 4) = v1; }
                    }
                }
            }
    }
};
__device__ __forceinline__ void dil_attn_prompt_task(int b, int h, int x, const bf16* KVP, bf16* ATT, float* LSE, LAS unsigned char* vl, int lane_in) {
    const int lane = lane_id(); (void)lane_in;
    const int qi = lane & 31, hh = lane >> 5, g = h >> 2;
    const int dil = g == 0 ? 1 : (g == 1 ? 4 : 16), nb = (SEQ / 32) / dil;
    const int r = x / nb, i0 = (x % nb) * 32;
    const float slope2 = __builtin_amdgcn_exp2f(-8.0f * (float)(h + 1) / 12.0f) * (float)dil * 1.4426950408889634f;
    const float c2 = 0.125f * 1.4426950408889634f;
    const bf16* base = KVP + (size_t)b * SEQ * KVW + h * 64;
    const size_t qrow = (size_t)(r + dil * (i0 + qi)) * KVW;
    bf16x8 qf[4];
#pragma unroll
    for (int ks = 0; ks < 4; ++ks) qf[ks] = *(const bf16x8*)(base + qrow + 1536 + 16 * ks + 8 * hh);
    const int kt0 = i0 >= 128 ? 0 : (128 - i0) / 32;
    const int ik0 = i0 - 128 + qi;
    float mx = -1e30f;
    {
        bf16x8 kf[4], kn[4];
        load_kfrag(kf, base + (size_t)(r + dil * (ik0 + 32 * kt0)) * KVW, hh);
#pragma unroll 1
        for (int kt = kt0; kt < 5; ++kt) {
            if (kt + 1 < 5) load_kfrag(kn, base + (size_t)(r + dil * (ik0 + 32 * (kt + 1))) * KVW, hh);
            const f32x16 st = qk_mma(kf, qf);
#pragma unroll
            for (int rr = 0; rr < 16; ++rr) {
                const int kk = (rr & 3) + 8 * (rr >> 2) + 4 * hh, m = qi + 128 - 32 * kt - kk;
                const float s2 = st[rr] * c2 - slope2 * (float)m;
                mx = (m >= 0 && m <= 128) ? fmaxf(mx, s2) : mx;
            }
#pragma unroll
            for (int ks = 0; ks < 4; ++ks) kf[ks] = kn[ks];
        }
    }
    mx = half_max(mx);
    float l = 0.f;
    f32x16 o[2] = {};
    {
        bf16x8 kf[4], kn[4]; v4u vt[4], vn[4];
        load_kfrag(kf, base + (size_t)(r + dil * (ik0 + 32 * kt0)) * KVW, hh);
        { const int ikb = i0 - 128 + 32 * kt0; load_v_tile(vt, [&](int key) { return base + (size_t)(r + dil * (ikb + key)) * KVW + 768; }, lane); }
#pragma unroll 1
        for (int kt = kt0; kt < 5; ++kt) {
            if (kt + 1 < 5) { load_kfrag(kn, base + (size_t)(r + dil * (ik0 + 32 * (kt + 1))) * KVW, hh);
                              const int ikb = i0 - 128 + 32 * (kt + 1); load_v_tile(vn, [&](int key) { return base + (size_t)(r + dil * (ikb + key)) * KVW + 768; }, lane); }
            f32x16 st = qk_mma(kf, qf);
#pragma unroll
            for (int rr = 0; rr < 16; ++rr) {
                const int kk = (rr & 3) + 8 * (rr >> 2) + 4 * hh, m = qi + 128 - 32 * kt - kk;
                const float e = (m >= 0 && m <= 128) ? __builtin_amdgcn_exp2f(st[rr] * c2 - slope2 * (float)m - mx) : 0.f;
                st[rr] = e; l += e;
            }
            write_v_tile(vl, vt, lane);
            LDS_WAIT();
            pv_tile(o, st, vl, lane);
            LDS_WAIT();
#pragma unroll
            for (int ks = 0; ks < 4; ++ks) { kf[ks] = kn[ks]; vt[ks] = vn[ks]; }
        }
    }
    l = half_sum(l);
    const float il = 1.f / l;
    if (hh == 0) LSE[((size_t)b * SEQ + r + dil * (i0 + qi)) * NH + h] = mx + __builtin_amdgcn_logf(l);
#pragma unroll
    for (int rr = 0; rr < 16; ++rr) {
        const int q = (rr & 3) + 8 * (rr >> 2) + 4 * hh;
        const float ilq = __shfl(il, q);
        const size_t row = (size_t)b * SEQ + r + dil * (i0 + q);
#pragma unroll
        for (int db = 0; db < 2; ++db) ATT[row * MIX + h * 64 + db * 32 + qi] = (bf16)f2bf(o[db][rr] * ilq);
    }
}
__device__ __forceinline__ void dil_attn_sample_wg(int srow, const bf16* KVP, const float* buf1, const float* buf4, const float* buf16, bf16* A1, LAS float* scs, LAS f32x4* red, LAS float* msc, int wave) {
    const int lane = lane_id();
    const int b = srow >> 2, t = srow & 3, li = lane & 15, j = lane >> 4, l4 = lane * 4;
    const size_t row = (size_t)MP + srow;
    LAS float* sch = scs + j * SCP;
    const float c2 = 0.125f * 1.4426950408889634f;
#pragma unroll 1
    for (int g = 0; g < 3; ++g) {
        const int dil = g == 0 ? 1 : (g == 1 ? 4 : 16), Lb = g == 0 ? 128 : (g == 1 ? 512 : 2048);
        const float* buf = (g == 0 ? buf1 : (g == 1 ? buf4 : buf16)) + (size_t)b * Lb * 512;
        const float slope2 = __builtin_amdgcn_exp2f(-8.0f * (float)(4 * g + j + 1) / 12.0f) * (float)dil * 1.4426950408889634f;
        f32x4 q4 = bf4_to_f4(*(const v2u*)(KVP + row * KVW + 1536 + g * 256 + l4)); q4 = q4 * c2;
        const int mnew = g == 0 ? t + 1 : 1;
        const bf16* knew = KVP + ((size_t)MP + b * 4) * KVW + g * 256 + l4;
        if (wave == 0)
            for (int m = 0; m < mnew; ++m) {
                const f32x4 kk = bf4_to_f4(*(const v2u*)(knew + (size_t)(t - m * dil) * KVW));
                const float d = red16(q4.x * kk.x + q4.y * kk.y + q4.z * kk.z + q4.w * kk.w);
                if (li == 0) sch[m] = d - slope2 * (float)m;
            }
        {
            f32x4 kk[16];
#pragma unroll
            for (int i = 0; i < 16; ++i) { int m = mnew + wave + 8 * i; m = m <= 128 ? m : 128; kk[i] = *(const f32x4*)(buf + (size_t)(Lb + t - m * dil) * 512 + l4); }
#pragma unroll
            for (int i = 0; i < 16; ++i) { const int m = mnew + wave + 8 * i; const float d = red16(q4.x * kk[i].x + q4.y * kk[i].y + q4.z * kk[i].z + q4.w * kk[i].w);
                if (li == i && m <= 128) sch[m] = d - slope2 * (float)m; }
        }
        LDS_WAIT(); __syncthreads();
        float mx = -1e30f;
        for (int m = li; m <= 128; m += 16) mx = fmaxf(mx, sch[m]);
        mx = max16(mx);
        float sum = 0.f;
        for (int m = li; m <= 128; m += 16) sum += __builtin_amdgcn_exp2f(sch[m] - mx);
        sum = red16(sum);
        f32x4 o4 = {0.f, 0.f, 0.f, 0.f};
        if (wave == 0)
            for (int m = 0; m < mnew; ++m) o4 = o4 + bf4_to_f4(*(const v2u*)(knew + (size_t)(t - m * dil) * KVW + 768)) * __builtin_amdgcn_exp2f(sch[m] - mx);
        {
            f32x4 vv[16];
#pragma unroll
            for (int i = 0; i < 16; ++i) { int m = mnew + wave + 8 * i; m = m <= 128 ? m : 128; vv[i] = *(const f32x4*)(buf + (size_t)(Lb + t - m * dil) * 512 + 256 + l4); }
#pragma unroll
            for (int i = 0; i < 16; ++i) { const int m = mnew + wave + 8 * i; const float pw = m <= 128 ? __builtin_amdgcn_exp2f(sch[m <= 128 ? m : 128] - mx) : 0.f; o4 = o4 + vv[i] * pw; }
        }
        red[wave * 64 + lane] = o4;
        LDS_WAIT(); __syncthreads();
        if (wave == 0) {
            f32x4 o = red[lane];
#pragma unroll
            for (int w = 1; w < 8; ++w) o = o + red[w * 64 + lane];
            o = o * (1.f / sum);
            msc[(g * 5 + 0) * 64 + lane] = o.x; msc[(g * 5 + 1) * 64 + lane] = o.y; msc[(g * 5 + 2) * 64 + lane] = o.z; msc[(g * 5 + 3) * 64 + lane] = o.w;
            msc[(g * 5 + 4) * 64 + lane] = mx + __builtin_amdgcn_logf(sum);
        }
        LDS_WAIT(); __syncthreads();
    }
    if (wave == 0) {
        f32x4 og[3]; float lse[3];
#pragma unroll
        for (int g = 0; g < 3; ++g) { og[g] = (f32x4){msc[(g * 5 + 0) * 64 + lane], msc[(g * 5 + 1) * 64 + lane], msc[(g * 5 + 2) * 64 + lane], msc[(g * 5 + 3) * 64 + lane]}; lse[g] = msc[(g * 5 + 4) * 64 + lane]; }
        const float M = fmaxf(lse[0], fmaxf(lse[1], lse[2]));
        const float e0 = __builtin_amdgcn_exp2f(lse[0] - M), e1 = __builtin_amdgcn_exp2f(lse[1] - M), e2 = __builtin_amdgcn_exp2f(lse[2] - M);
        const float iden = 1.f / (e0 + e1 + e2);
        const float wg[3] = {e0 * iden, e1 * iden, e2 * iden};
#pragma unroll
        for (int g = 0; g < 3; ++g) {
            const f32x4 g4 = bf4_to_f4(*(const v2u*)(KVP + row * KVW + 2304 + g * 256 + l4));
            const f32x4 v = og[g] * wg[g];
            v2u w; w.x = pk2(v.x * fast_silu(g4.x), v.y * fast_silu(g4.y)); w.y = pk2(v.z * fast_silu(g4.z), v.w * fast_silu(g4.w));
            *(v2u*)(A1 + row * DM + g * 256 + l4) = w;
        }
    }
    LDS_WAIT(); __syncthreads();
}
__device__ __forceinline__ void dil_attn_phase(Frame& F, int flags, const float* const* in) {
    const bf16* KVP = (const bf16*)(F.ws + WS_KVP); bf16* ATT = (bf16*)(F.ws + WS_ATT); float* LSE = (float*)(F.ws + WS_LSE);
    LDS_WAIT(); __syncthreads();
    const bool two_roles = F.G > NSW;
    if (!two_roles || F.vcu < NSW) {
        if (!(flags & 8))
        for (int srow = F.vcu; srow < MS; srow += (two_roles ? NSW : F.G))
            dil_attn_sample_wg(srow, KVP, in[5], in[6], in[7], (bf16*)(F.ws + WS_A1), (LAS float*)(F.lds + RING_OFF), (LAS f32x4*)(F.lds + RING_OFF + 8192), (LAS float*)(F.lds + RING_OFF + 16384), F.wave);
    }
    if (!two_roles || F.vcu >= NSW) {
        const int nwg = two_roles ? F.G - NSW : F.G, wgi = two_roles ? F.vcu - NSW : F.vcu;
        const int gw = wgi * NWAVES + F.wave, NGW = nwg * NWAVES;
        LAS unsigned char* wl = F.lds + RING_OFF + F.wave * 16384;
        constexpr int NT_P = BP * NH * (SEQ / 32);
        if (!(flags & 16))
        for (int tp = gw; tp < NT_P; tp += NGW) { const int x = tp % (SEQ / 32), bh = tp / (SEQ / 32), h = bh % NH, b = bh / NH; dil_attn_prompt_task(b, h, x, KVP, ATT, LSE, wl, 0); }
    }
}
__device__ __forceinline__ void merge_gate_phase(Frame& F) {
    const bf16* KVP = (const bf16*)(F.ws + WS_KVP); const bf16* ATT = (const bf16*)(F.ws + WS_ATT); const float* LSE = (const float*)(F.ws + WS_LSE); bf16* A1 = (bf16*)(F.ws + WS_A1);
    const size_t gt = (size_t)F.vcu * NWAVES * 64 + TID_OF(F), nth = (size_t)F.G * NWAVES * 64;
    for (size_t i = gt; i < (size_t)MP * (MIX / 8); i += nth) {
        const size_t row = i / (MIX / 8); const int c = (int)(i % (MIX / 8)) * 8, h = c >> 6, j = h & 3;
        const float l0 = LSE[row * NH + j], l1 = LSE[row * NH + 4 + j], l2 = LSE[row * NH + 8 + j];
        const float mx = fmaxf(l0, fmaxf(l1, l2));
        const float den = __builtin_amdgcn_exp2f(l0 - mx) + __builtin_amdgcn_exp2f(l1 - mx) + __builtin_amdgcn_exp2f(l2 - mx);
        const float w = __builtin_amdgcn_exp2f(LSE[row * NH + h] - mx) / den;
        const v4u av = *(const v4u*)(ATT + row * MIX + c), gv = *(const v4u*)(KVP + row * KVW + 2304 + c);
        v4u o;
        o.x = pk2(pg8::bf_lo(av.x) * w * fast_silu(pg8::bf_lo(gv.x)), pg8::bf_hi(av.x) * w * fast_silu(pg8::bf_hi(gv.x)));
        o.y = pk2(pg8::bf_lo(av.y) * w * fast_silu(pg8::bf_lo(gv.y)), pg8::bf_hi(av.y) * w * fast_silu(pg8::bf_hi(gv.y)));
        o.z = pk2(pg8::bf_lo(av.z) * w * fast_silu(pg8::bf_lo(gv.z)), pg8::bf_hi(av.z) * w * fast_silu(pg8::bf_hi(gv.z)));
        o.w = pk2(pg8::bf_lo(av.w) * w * fast_silu(pg8::bf_lo(gv.w)), pg8::bf_hi(av.w) * w * fast_silu(pg8::bf_hi(gv.w)));
        *(v4u*)(A1 + row * DM + c) = o;
    }
}
#ifndef REP_LO
#define REP_LO 0
#define REP_HI 0
#endif
#ifndef REP_FLAGS
#define REP_FLAGS 0
#endif
struct Args { const float* in[25]; float* out; unsigned char* ws; int ph_lo, ph_hi, flags, pad; };
__global__ void __launch_bounds__(NWAVES * 64, 2) fwd(Args args) {
    extern __shared__ __attribute__((aligned(16))) unsigned char lds[];
    Frame F;
    F.lds = (LAS unsigned char*)lds;
    F.MISC = (volatile LAS unsigned*)(F.lds + MISC_OFF);
    F.wave = __builtin_amdgcn_readfirstlane((int)threadIdx.x >> 6);
    F.G = gridDim.x; { const int bx = blockIdx.x; F.vcu = (F.G % 8 == 0) ? (bx % 8) * (F.G / 8) + bx / 8 : bx; }
    F.ws = args.ws; F.out = args.out;
    F.ctl = (gu32*)(F.ws + WS_CTL);
    F.cc.src = nullptr; F.cc.dst = nullptr; F.cc.n = 0; F.cc.cnt = 0;
    const int bslot = (int)blockIdx.x >> 3, bxcd = (int)blockIdx.x & 7; const bool split = (F.G == 256);
    constexpr int NS1 = 24, NS4 = 25, NS5 = 24, NS7 = 29, NS10 = 24;
    constexpr int CQ1 = 240, CQ4 = 100, CQ5 = 170, CQ7 = 330, CQ10 = 170;
    constexpr int CB1 = 0, CB4 = CB1 + (32 - NS1) * 8 * CQ1, CB5 = CB4 + (32 - NS4) * 8 * CQ4, CB7 = CB5 + (32 - NS5) * 8 * CQ5, CB10 = CB7 + (32 - NS7) * 8 * CQ7, CBREST = CB10 + (32 - NS10) * 8 * CQ10;
    static_assert(CBREST <= CP_TOTAL, "copy quotas exceed the piece space");
#define ROLE_COMPUTE(NS) (!split || bslot < (NS))
#define ROLE_G(NS) (split ? (NS) * 8 : F.G)
#define ROLE_C(NS) (split ? bslot * 8 + bxcd : (int)blockIdx.x)
#define ROLE_COPY(NS, CB, CQ) copy_pieces<8>(args.in, F.out, (CB), (CB) + (32 - (NS)) * 8 * (CQ), (bslot - (NS)) * 8 + bxcd, (32 - (NS)) * 8, TID_OF(F))
    for (int u = TID_OF(F); u < (LDS_BYTES - LDSCTL_OFF) / 4; u += NWAVES * 64) ((LAS unsigned*)(F.lds + LDSCTL_OFF))[u] = 0u;
    __syncthreads();
    XcdBarrier bar = xcd_barrier_post((unsigned*)(F.ctl + CW_BAR), F.MISC + 8, F.wave);
    const int lo = args.ph_lo, hi = args.ph_hi;
#define IN(k) (lo <= (k) && (k) < hi)
#define BOTH(k) (IN(k) && IN((k) + 1))
    if (IN(0)) { p0_prologue(F, args.in);
        copy_pieces<8>(args.in, F.out, split ? CBREST : 0, CP_TOTAL, F.vcu, F.G, TID_OF(F));


 if (BOTH(0)) xcd_barrier(bar, F.wave); }
    if (IN(1)) {
        {
            pg8::Gemm g{(const bf16*)(F.ws + WS_XB), (const bf16*)(F.ws + WS_WIN0), 1024, 1024, 1024, 0, 0};
            if (ROLE_COMPUTE(NS1)) {
            pg8::StaticOrder S; S.init(MT, INW, ROLE_G(NS1), ROLE_C(NS1));
            EpiProj0 E{(bf16*)(F.ws + WS_UGH), (bf16*)(F.ws + WS_US), (bf16*)(F.ws + WS_PROJR)};
            pg8::gemm_phase<EpiProj0, pg8::StaticOrder, true, false>(F.lds + RING_OFF, g, S, E, F.wave, F.cc);
            } else ROLE_COPY(NS1, CB1, CQ1);
        }
        {
            pg8::Gemm g{(const bf16*)(F.ws + WS_MEMB), (const bf16*)(F.ws + WS_WMEM), 1024, 1024, 1024, 0, 0};
            pg8::StaticOrder S; S.init(BP * NMEM, 1024, ROLE_G(NS1), ROLE_COMPUTE(NS1) ? (split ? (ROLE_C(NS1) + ROLE_G(NS1) - 144) % ROLE_G(NS1) : (int)((blockIdx.x + 192u) % (unsigned)F.G)) : 1 << 20);
            EpiMemKV E{F.out, (bf16*)(F.ws + WS_MKVB)};
            pg8::gemm_phase<EpiMemKV, pg8::StaticOrder, true, false>(F.lds + RING_OFF, g, S, E, F.wave, F.cc);
        }
        if (BOTH(1)) xcd_barrier(bar, F.wave);
    }
    if (IN(2)) {
        pg8::Gemm g{(const bf16*)(F.ws + WS_UGH), (const bf16*)(F.ws + WS_PT), UGK, 256, 256, (size_t)1024 * UGK, (size_t)256 * 256};
        pg8::BatchOrder S; S.init(NG, 4, F.G, (int)blockIdx.x);
        EpiS E{(float*)(F.ws + WS_SST)};
        pg8::gemm_phase<EpiS, pg8::BatchOrder, true, false>(F.lds + RING_OFF, g, S, E, F.wave, F.cc);
        if (BOTH(2)) xcd_barrier(bar, F.wave);
    }
    if (IN(3)) {
        pg8::Gemm g{(const bf16*)(F.ws + WS_UGH), (const bf16*)(F.ws + WS_TQ), UGK, UGK, UGK, (size_t)1024 * UGK, (size_t)256 * UGK};
        pg8::BatchOrder S; S.init(NG, 4, F.G, (int)blockIdx.x);
        { pg8::Unit u; for (int i = 0; S.next(i, u); ++i) s5_carry_scan(u, (const float*)(F.ws + WS_SST), (bf16*)(F.ws + WS_UGH), (const float*)(F.ws + WS_TAB), F.out, TID_OF(F)); }
        VM_WAIT(); __syncthreads();
        EpiY E{(bf16*)(F.ws + WS_Y)};
        pg8::gemm_phase<EpiY, pg8::BatchOrder, true, false>(F.lds + RING_OFF, g, S, E, F.wave, F.cc);
        {
            const int lane = lane_id();
            const float* TAB = (const float*)(F.ws + WS_TAB);
            if ((int)blockIdx.x >= NG * 4) {
                const int nw = (F.G - NG * 4) * NWAVES;
                for (int task = ((int)blockIdx.x - NG * 4) * NWAVES + F.wave; task < 4096; task += nw)
                    s5_sample_task(task / NG, task % NG, args.in, TAB, (const bf16*)(F.ws + WS_US), (bf16*)(F.ws + WS_Y), F.out, lane);
            } else {
                for (int task = 4096 + (int)blockIdx.x * NWAVES + F.wave; task < BS * NG; task += NG * 4 * NWAVES)
                    s5_sample_task(task / NG, task % NG, args.in, TAB, (const bf16*)(F.ws + WS_US), (bf16*)(F.ws + WS_Y), F.out, lane);
            }
        }
        if (BOTH(3)) xcd_barrier(bar, F.wave);
    }
    if (IN(4)) {
        pg8::Gemm g{(const bf16*)(F.ws + WS_Y), (const bf16*)(F.ws + WS_WGLU), MIX, MIX, MIX, 0, 0};
        pg8::StaticOrder S; S.init(MT, MIX, ROLE_G(NS4), ROLE_COMPUTE(NS4) ? ROLE_C(NS4) : 1 << 20);
        if (!ROLE_COMPUTE(NS4) && !(args.flags & 1)) ROLE_COPY(NS4, CB4, CQ4);
        EpiGlu E{(const bf16*)(F.ws + WS_Y), (const bf16*)(F.ws + WS_PROJR), args.in[23], (bf16*)(F.ws + WS_A1)};
        if (!(args.flags & 1)) pg8::gemm_phase<EpiGlu, pg8::StaticOrder, true, false>(F.lds + RING_OFF, g, S, E, F.wave, F.cc);
        mem_attn_phase(F, args.flags, 0, (const bf16*)(F.ws + WS_PROJR) + MIX, (const bf16*)(F.ws + WS_PROJR) + MIX + 256, PRW, args.in[2], (bf16*)(F.ws + WS_A1));
        if (BOTH(4)) xcd_barrier(bar, F.wave);
    }
    if (IN(5)) {
        pg8::Gemm g{(const bf16*)(F.ws + WS_A1), (const bf16*)(F.ws + WS_WOUT0), DM, DM, DM, 0, 0};
        pg8::StaticOrder S; S.init(MT, DM, ROLE_G(NS5), ROLE_COMPUTE(NS5) ? ROLE_C(NS5) : 1 << 20);
        if (!ROLE_COMPUTE(NS5)) ROLE_COPY(NS5, CB5, CQ5);
        EpiR E{args.in[0], args.in[1], (float*)(F.ws + WS_R)};
        pg8::gemm_phase<EpiR, pg8::StaticOrder, true, false>(F.lds + RING_OFF, g, S, E, F.wave, F.cc);
        if (BOTH(5)) xcd_barrier(bar, F.wave);
    }
    if (IN(6)) {
        ln_phase(F, (const float*)(F.ws + WS_R), args.in[11], args.in[12], (float*)(F.ws + WS_X1), (bf16*)(F.ws + WS_X1B));
        if (BOTH(6)) xcd_barrier(bar, F.wave);
    }
    if (IN(7)) {
        pg8::Gemm g{(const bf16*)(F.ws + WS_X1B), (const bf16*)(F.ws + WS_WB1), DM, DM, DM, 0, 0};
        pg8::StaticOrder S; S.init(MT, KVW, ROLE_G(NS7), ROLE_COMPUTE(NS7) ? ROLE_C(NS7) : 1 << 20);
        if (!ROLE_COMPUTE(NS7)) ROLE_COPY(NS7, CB7, CQ7);
        EpiKVQ E{(bf16*)(F.ws + WS_KVP), F.out};
        pg8::gemm_phase<EpiKVQ, pg8::StaticOrder, true, false>(F.lds + RING_OFF, g, S, E, F.wave, F.cc);
        if (BOTH(7)) xcd_barrier(bar, F.wave);
    }
    if (IN(8)) {
        dil_attn_phase(F, args.flags, args.in);
        mem_attn_phase(F, args.flags, 1, (const bf16*)(F.ws + WS_KVP) + 3072, (const bf16*)(F.ws + WS_KVP) + 3328, KVW, args.in[2], (bf16*)(F.ws + WS_A1));
        if (BOTH(8)) xcd_barrier(bar, F.wave);
    }
    if (IN(9)) { merge_gate_phase(F); if (BOTH(9)) xcd_barrier(bar, F.wave); }
    if (IN(10)) {
        pg8::Gemm g{(const bf16*)(F.ws + WS_A1), (const bf16*)(F.ws + WS_WOUT1), DM, DM, DM, 0, 0};
        pg8::StaticOrder S; S.init(MT, DM, ROLE_G(NS10), ROLE_COMPUTE(NS10) ? ROLE_C(NS10) : 1 << 20);
        if (!ROLE_COMPUTE(NS10)) ROLE_COPY(NS10, CB10, CQ10);
        EpiR E{(const float*)(F.ws + WS_X1), (const float*)(F.ws + WS_X1) + (size_t)MP * DM, (float*)(F.ws + WS_R)};
        pg8::gemm_phase<EpiR, pg8::StaticOrder, true, false>(F.lds + RING_OFF, g, S, E, F.wave, F.cc);
        if (BOTH(10)) xcd_barrier(bar, F.wave);
    }
    if (IN(11)) { ln_phase(F, (const float*)(F.ws + WS_R), args.in[11] + DM, args.in[12] + DM, F.out + O_Y, nullptr); }
#undef IN
#undef BOTH
}

__global__ void cvt_proj0(const bf16* UGH, const bf16* US, const bf16* PROJR, float* PROJ) {
    const size_t i = (size_t)blockIdx.x * blockDim.x + threadIdx.x;
    if (i >= (size_t)MT * INW) return;
    const int row = (int)(i / INW), col = (int)(i % INW);
    bf16 v;
    if (col < MIX) {
        if (row < MP) { const int b = row >> 11, t = row & 2047, g = col >> 4; v = UGH[(size_t)(g * 1024 + b * 128 + (t >> 4)) * UGK + (t & 15) * 16 + (col & 15)]; }
        else v = US[(size_t)(row - MP) * MIX + col];
    } else v = PROJR[(size_t)row * PRW + (col - MIX)];
    PROJ[i] = bf2f(v);
}

__global__ void cvt_bf16_f32(const bf16* src, float* dst, size_t n) {
    const size_t i = (size_t)blockIdx.x * blockDim.x + threadIdx.x;
    if (i < n) dst[i] = bf2f(src[i]);
}
__global__ void cvt_kvp(const bf16* KVP, float* KV, float* PROJ) {
    const size_t i = (size_t)blockIdx.x * blockDim.x + threadIdx.x;
    if (i >= (size_t)MT * KVW) return;
    const size_t row = i / KVW; const int col = (int)(i % KVW);
    const float v = bf2f(KVP[i]);
    if (col < 1536) KV[row * 1536 + col] = v; else PROJ[row * 2048 + (col - 1536)] = v;
}
extern "C" void kernel_launch(void* const* d_in, const int* in_sizes, int n_in, void* d_out, int out_size, void* d_ws, size_t ws_size, hipStream_t stream) {
    static int grid = 0;
    if (grid == 0) {
        int dev = 0, cus = 0, per_cu = 0;
        if (hipGetDevice(&dev) != hipSuccess || hipDeviceGetAttribute(&cus, hipDeviceAttributeMultiprocessorCount, dev) != hipSuccess) { fprintf(stderr, "kernel_launch: device query failed\n"); grid = -1; return; }
        if (hipFuncSetAttribute((const void*)fwd, hipFuncAttributeMaxDynamicSharedMemorySize, LDS_BYTES) != hipSuccess) { fprintf(stderr, "kernel_launch: hipFuncSetAttribute failed\n"); grid = -1; return; }
        if (hipOccupancyMaxActiveBlocksPerMultiprocessor(&per_cu, (const void*)fwd, NWAVES * 64, LDS_BYTES) != hipSuccess || per_cu < 1) { fprintf(stderr, "kernel_launch: occupancy query says %d\n", per_cu); per_cu = 1; }
        (void)hipGetLastError();
        grid = cus * 1;
        if (per_cu != 1) fprintf(stderr, "kernel_launch: note: occupancy query reports %d blocks/CU\n", per_cu);
    }
    if (grid < 0) return;
    hipMemsetAsync((char*)d_ws + WS_CTL, 0, CTL_ZERO_BYTES, stream);
    Args a{};
    for (int i = 0; i < 25; ++i) a.in[i] = (const float*)d_in[i];
    a.out = (float*)d_out; a.ws = (unsigned char*)d_ws; a.ph_lo = 0; a.ph_hi = 12;
    void* kargs[] = {&a};
    hipError_t e = hipLaunchCooperativeKernel((const void*)fwd, dim3(grid), dim3(NWAVES * 64), kargs, LDS_BYTES, stream);
    if (e != hipSuccess) fprintf(stderr, "kernel_launch: cooperative launch failed: %s\n", hipGetErrorString(e));
#if REP_HI > REP_LO
    hipMemsetAsync((char*)d_ws + WS_CTL, 0, CTL_ZERO_BYTES, stream);
    Args a2 = a; a2.ph_lo = REP_LO; a2.ph_hi = REP_HI; a2.flags = REP_FLAGS; void* kargs2[] = {&a2};
    hipLaunchCooperativeKernel((const void*)fwd, dim3(grid), dim3(NWAVES * 64), kargs2, LDS_BYTES, stream);
#endif

}
```
